# Optimizing an MI355X kernel written in HIP

```python
import jax, jax.numpy as jnp
from jax import lax
import numpy as np

D_MODEL = 1024
BATCH = 4
SEQ = 8192
DEPTH = 2
DEC_BATCH = 16
DEC_SEQ = 32
PAST_LEN = 4096

CHUNK = 64
N_A = DEPTH // 2
N_B = DEPTH - N_A
SGU_BLOCK = 128
SGU_GROUPS = 4
SGU_HALF = D_MODEL
SGU_GROUP_DIM = SGU_HALF // SGU_GROUPS
D_FF = 2816
CONV_W = 3
N_HEADS = 16
HEAD_DIM = D_MODEL // N_HEADS
Q_BLOCK = 128
EPS = 1e-6

kernel_name = 'yoco_gmlp_fox_streaming_encoder'


def rms_norm(x, g):
    xf = x.astype(jnp.float32)
    y = xf * lax.rsqrt(jnp.mean(xf * xf, axis=-1, keepdims=True) + EPS)
    return (y * g.astype(jnp.float32)).astype(x.dtype)


def layer_norm(x, g, b):
    xf = x.astype(jnp.float32)
    xc = xf - jnp.mean(xf, axis=-1, keepdims=True)
    y = xc * lax.rsqrt(jnp.mean(xc * xc, axis=-1, keepdims=True) + EPS)
    return (y * g.astype(jnp.float32) + b.astype(jnp.float32)).astype(x.dtype)


def sgu_mask(n):
    c = np.arange(n) // CHUNK
    return c[None, :] <= c[:, None]


def sgu_mixer(hn, w_in, ln_g, ln_b, w_s, b_s, w_out):
    bsz, s, _ = hn.shape
    blk = min(SGU_BLOCK, s)
    z = jax.nn.gelu(hn @ w_in)
    u, v = jnp.split(z, 2, axis=-1)
    v = layer_norm(v, ln_g, ln_b)
    mask = sgu_mask(SGU_BLOCK)[:blk, :blk]
    ws = jnp.where(mask[None], w_s[:, :blk, :blk], jnp.zeros((), w_s.dtype))
    vb = v.reshape(bsz, s // blk, blk, SGU_GROUPS, SGU_GROUP_DIM)
    mixed = jnp.einsum('gij,bnjgc->bnigc', ws, vb) + b_s[:, :blk].T[None, None, :, :, None]
    out = u * mixed.reshape(bsz, s, SGU_HALF)
    return out @ w_out, v


def conv_ffn(hn, conv_state, w_up, conv_w, conv_b, w_down):
    a = hn @ w_up
    s = a.shape[1]
    ext = jnp.concatenate([conv_state.astype(a.dtype), a], axis=1)
    c = sum(ext[:, k:k + s] * conv_w[k] for k in range(CONV_W)) + conv_b
    gate, val = jnp.split(c, 2, axis=-1)
    y = (jax.nn.silu(gate) * val) @ w_down
    return y, ext[:, -(CONV_W - 1):]


def shared_kv(h, kv_norm, w_k, w_v, k_norm_g, w_f, b_f):
    bsz, s, _ = h.shape
    hn = rms_norm(h, kv_norm)
    k = rms_norm((hn @ w_k).reshape(bsz, s, N_HEADS, HEAD_DIM), k_norm_g)
    v = (hn @ w_v).reshape(bsz, s, N_HEADS, HEAD_DIM)
    logf = jax.nn.log_sigmoid((hn @ w_f).astype(jnp.float32) + b_f.astype(jnp.float32))
    return k, v, logf


def fox_attention(q, k, v, cq, ck, q_off):
    bsz, sq, _, _ = q.shape
    sk = k.shape[1]
    blk = min(Q_BLOCK, sq)
    nb = sq // blk
    scale = HEAD_DIM ** -0.5
    kpos = jnp.arange(sk, dtype=jnp.int32)
    ck_t = ck.astype(jnp.float32).transpose(0, 2, 1)[:, :, None, :]

    def one_block(args):
        qb, cqb, qpos = args
        logits = jnp.einsum('bqhd,bkhd->bhqk', qb, k, preferred_element_type=jnp.float32) * scale
        logits = logits + cqb.astype(jnp.float32).transpose(0, 2, 1)[..., None] - ck_t
        mask = kpos[None, :] <= qpos[:, None]
        p = jax.nn.softmax(jnp.where(mask, logits, -jnp.inf), axis=-1)
        return jnp.einsum('bhqk,bkhd->bqhd', p.astype(v.dtype), v)

    qs = q.reshape(bsz, nb, blk, N_HEADS, HEAD_DIM).transpose(1, 0, 2, 3, 4)
    cqs = cq.reshape(bsz, nb, blk, N_HEADS).transpose(1, 0, 2, 3)
    qposs = (q_off + jnp.arange(sq, dtype=jnp.int32)).reshape(nb, blk)
    out = lax.map(one_block, (qs, cqs, qposs))
    return out.transpose(1, 0, 2, 3, 4).reshape(bsz, sq, N_HEADS * HEAD_DIM)


def run_group(x, conv_in, past, w):
    bsz, s, _ = x.shape
    q_off = 0 if past is None else past[0].shape[1]
    h = x
    sgu_rows, conv_rows = [], []
    shared = None
    for layer in range(DEPTH):
        hn = rms_norm(h, w['norm_mix'][layer])
        if layer < N_A:
            mix, v_rows = sgu_mixer(hn, w['a_w_in'][layer], w['a_ln_g'][layer], w['a_ln_b'][layer],
                                    w['a_w_s'][layer], w['a_b_s'][layer], w['a_w_out'][layer])
            sgu_rows.append(v_rows)
        else:
            if shared is None:
                k_new, v_new, lf_new = shared_kv(h, w['kv_norm'], w['w_k'], w['w_v'],
                                                 w['k_norm_g'], w['w_f'], w['b_f'])
                if past is None:
                    k_all, v_all, lf_all = k_new, v_new, lf_new
                else:
                    k_all = jnp.concatenate([past[0].astype(k_new.dtype), k_new], axis=1)
                    v_all = jnp.concatenate([past[1].astype(v_new.dtype), v_new], axis=1)
                    lf_all = jnp.concatenate([past[2].astype(jnp.float32), lf_new], axis=1)
                c_all = jnp.cumsum(lf_all.astype(jnp.float32), axis=1)
                shared = (k_all, v_all, c_all)
            j = layer - N_A
            q = rms_norm((hn @ w['b_w_q'][j]).reshape(bsz, s, N_HEADS, HEAD_DIM), w['q_norm_g'][j])
            att = fox_attention(q, shared[0], shared[1], shared[2][:, q_off:], shared[2], q_off)
            mix = att @ w['b_w_o'][j]
        h = h + mix
        y, conv_new = conv_ffn(rms_norm(h, w['norm_ffn'][layer]), conv_in[layer], w['f_w_up'][layer],
                               w['f_conv_w'][layer], w['f_conv_b'][layer], w['f_w_down'][layer])
        conv_rows.append(conv_new)
        h = h + y
    return h, jnp.stack(sgu_rows), jnp.stack(conv_rows), k_new, v_new, lf_new


def setup_inputs(seed: int = 0) -> dict:
    key = jax.random.key(seed)
    ks = jax.random.split(key, 32)

    def nrm(k, shape, scale=1.0):
        return jax.random.normal(k, shape, jnp.float32) * scale

    hd = N_HEADS * HEAD_DIM
    return {
        'x_prompt': nrm(ks[0], (BATCH, SEQ, D_MODEL)),
        'x_sample': nrm(ks[1], (DEC_BATCH, DEC_SEQ, D_MODEL)),
        'cache_k': nrm(ks[2], (DEC_BATCH, PAST_LEN, N_HEADS, HEAD_DIM)),
        'cache_v': nrm(ks[3], (DEC_BATCH, PAST_LEN, N_HEADS, HEAD_DIM)),
        'cache_logf': jax.nn.log_sigmoid(3.0 + nrm(ks[4], (DEC_BATCH, PAST_LEN, N_HEADS))),
        'cache_ffn_conv': nrm(ks[5], (DEPTH, DEC_BATCH, CONV_W - 1, 2 * D_FF)),
        'norm_mix': 1.0 + nrm(ks[6], (DEPTH, D_MODEL), 0.01),
        'norm_ffn': 1.0 + nrm(ks[7], (DEPTH, D_MODEL), 0.01),
        'a_w_in': nrm(ks[8], (N_A, D_MODEL, 2 * SGU_HALF), D_MODEL ** -0.5),
        'a_ln_g': 1.0 + nrm(ks[9], (N_A, SGU_HALF), 0.01),
        'a_ln_b': nrm(ks[10], (N_A, SGU_HALF), 0.01),
        'a_w_s': nrm(ks[11], (N_A, SGU_GROUPS, SGU_BLOCK, SGU_BLOCK), 0.5 * SGU_BLOCK ** -0.5),
        'a_b_s': 1.0 + nrm(ks[12], (N_A, SGU_GROUPS, SGU_BLOCK), 0.01),
        'a_w_out': nrm(ks[13], (N_A, SGU_HALF, D_MODEL), SGU_HALF ** -0.5),
        'f_w_up': nrm(ks[14], (DEPTH, D_MODEL, 2 * D_FF), D_MODEL ** -0.5),
        'f_conv_w': nrm(ks[15], (DEPTH, CONV_W, 2 * D_FF), CONV_W ** -0.5),
        'f_conv_b': nrm(ks[16], (DEPTH, 2 * D_FF), 0.01),
        'f_w_down': nrm(ks[17], (DEPTH, D_FF, D_MODEL), D_FF ** -0.5),
        'kv_norm': 1.0 + nrm(ks[18], (D_MODEL,), 0.01),
        'w_k': nrm(ks[19], (D_MODEL, hd), D_MODEL ** -0.5),
        'w_v': nrm(ks[20], (D_MODEL, hd), D_MODEL ** -0.5),
        'k_norm_g': 1.0 + nrm(ks[21], (HEAD_DIM,), 0.01),
        'w_f': nrm(ks[22], (D_MODEL, N_HEADS), D_MODEL ** -0.5),
        'b_f': jax.random.uniform(ks[23], (N_HEADS,), jnp.float32, 1.0, 5.0),
        'b_w_q': nrm(ks[24], (N_B, D_MODEL, hd), D_MODEL ** -0.5),
        'q_norm_g': 1.0 + nrm(ks[25], (N_B, HEAD_DIM), 0.01),
        'b_w_o': nrm(ks[26], (N_B, hd, D_MODEL), hd ** -0.5),
    }


def reference(x_prompt, x_sample, cache_k, cache_v, cache_logf, cache_ffn_conv,
              norm_mix, norm_ffn, a_w_in, a_ln_g, a_ln_b, a_w_s, a_b_s, a_w_out,
              f_w_up, f_conv_w, f_conv_b, f_w_down,
              kv_norm, w_k, w_v, k_norm_g, w_f, b_f,
              b_w_q, q_norm_g, b_w_o):
    w = {
        'norm_mix': norm_mix, 'norm_ffn': norm_ffn,
        'a_w_in': a_w_in, 'a_ln_g': a_ln_g, 'a_ln_b': a_ln_b, 'a_w_s': a_w_s, 'a_b_s': a_b_s,
        'a_w_out': a_w_out,
        'f_w_up': f_w_up, 'f_conv_w': f_conv_w, 'f_conv_b': f_conv_b, 'f_w_down': f_w_down,
        'kv_norm': kv_norm, 'w_k': w_k, 'w_v': w_v, 'k_norm_g': k_norm_g, 'w_f': w_f, 'b_f': b_f,
        'b_w_q': b_w_q, 'q_norm_g': q_norm_g, 'b_w_o': b_w_o,
    }
    zero_conv = jnp.zeros((DEPTH, x_prompt.shape[0], CONV_W - 1, 2 * D_FF), x_prompt.dtype)
    y_prompt, _, conv_p, k_p, v_p, lf_p = run_group(x_prompt, zero_conv, None, w)
    y_sample, sgu_v_s, conv_s, k_s, v_s, lf_s = run_group(
        x_sample, cache_ffn_conv, (cache_k, cache_v, cache_logf), w)
    return (y_prompt, y_sample, sgu_v_s, conv_p, conv_s, k_p, v_p, lf_p, k_s, v_s, lf_s)
```

```cpp
#include <hip/hip_runtime.h>
#include <hip/hip_cooperative_groups.h>
#include <cstdio>
#include <cstdint>
namespace pg8 {
#define PG8_LAS __attribute__((address_space(3)))
typedef unsigned short bf16_t;
typedef short bf16x8 __attribute__((ext_vector_type(8)));
typedef float f32x4 __attribute__((ext_vector_type(4)));
typedef unsigned u32x4 __attribute__((ext_vector_type(4)));
constexpr int BM = 256, BK = 64, HALF = 128, HTB = HALF * BK * 2  , STAGE_BYTES = 8 * HTB, NXCD = 8, WGM = 8;

__host__ __device__ __forceinline__ int lds_byte(int r, int c) { const int st = (r >> 4) * 2 + (c >> 5), rr = r & 15, cc = c & 31, ob = rr * 64 + cc * 2; return st * 1024 + (ob ^ (((ob >> 9) & 1) << 5)); }
__host__ __device__ __forceinline__ void stage_rc(int b, int& R, int& C) { const int st = b / 1024, sb = b % 1024, swz = sb ^ (((sb >> 9) & 1) << 5); R = (st >> 1) * 16 + swz / 64; C = (st & 1) * 32 + (swz % 64) / 2; }
__host__ __device__ __forceinline__ int perm32(int rho) { const int n = rho >> 4, i = rho & 15; return 8 * (i >> 2) + 4 * n + (i & 3); }

struct Unit { int pm, pn; };
struct Gemm { const bf16_t* A; const bf16_t* Bt; int M, N, K, KL; };

struct StaticOrder {
    int nM, nN, nwg, G, c;
    __host__ __device__ void init(int M, int N, int G_, int c_) { nM = M / BM; nN = N / BM; nwg = nM * nN; G = G_; c = c_; }
    __host__ __device__ bool next(int i, Unit& u) const {
        const long L = (long)i * G + c; if (L >= nwg) return false;
        int wgid = (int)L; { const int q = nwg / NXCD, r = nwg % NXCD, xcd = wgid % NXCD, off = wgid / NXCD; wgid = (xcd < r ? xcd * (q + 1) : r * (q + 1) + (xcd - r) * q) + off; }
        const int nig = WGM * nN, gid = wgid / nig, fm = gid * WGM, gsz = (nM - fm) < WGM ? (nM - fm) : WGM;
        u.pm = fm + ((wgid % nig) % gsz); u.pn = (wgid % nig) / gsz; return true;
    }
    __device__ __forceinline__ void a_ready(const Unit&) const {}
    __device__ __forceinline__ void done(const Unit&) const {}
};

__device__ __forceinline__ unsigned cvt_pk_bf16(float lo, float hi) { unsigned r; asm volatile("v_cvt_pk_bf16_f32 %0, %1, %2" : "=v"(r) : "v"(lo), "v"(hi)); return r; }
typedef float f32x2 __attribute__((ext_vector_type(2)));
template <class Epi, class Sched, bool ALIGN_EPI = false, bool SP2 = false>
__device__ __forceinline__ void gemm_phase(PG8_LAS unsigned char* lds, const Gemm g, const Sched& S, const Epi& E, const int wv0) {
    int tid_ = (wv0 << 6) | (int)__builtin_amdgcn_mbcnt_hi(~0u, __builtin_amdgcn_mbcnt_lo(~0u, 0u)); asm volatile("" : "+v"(tid_));
    const int tid = tid_, wid = __builtin_amdgcn_readfirstlane(tid >> 6), lane = tid & 63, wr = wid >> 2, wc = wid & 3, fr = lane & 15, fq = lane >> 4;
    const int K = g.K, nt = (g.KL ? g.KL : K) / BK;
    unsigned voffA[2], voffB[2];
#pragma unroll
    for (int i = 0; i < 2; ++i) { int R, C; stage_rc(tid * 16 + i * 8192, R, C); const int Rb = Epi::PERM ? ((R & ~31) + perm32(R & 31)) : R;
        voffA[i] = (unsigned)(R * K + C) * 2u; voffB[i] = (unsigned)(Rb * K + C) * 2u; }
    const size_t kstep = (size_t)(BK * 2);
    const size_t hstep = (size_t)HALF * K * 2;
    const size_t tstep = 2 * hstep;
    const unsigned ldsw = (unsigned)wid * 1024u;
    const int aoff = lds_byte(wr * 64 + fr, fq * 8), boff = lds_byte(wc * 32 + fr, fq * 8);
#define PG8_SA(b, h) (((b) * 2 + (h)) * HTB)
#define PG8_SB(b, h) ((4 + (b) * 2 + (h)) * HTB)
#define PG8_STAGE(bufoff, gbase, voff) do { _Pragma("unroll") for (int _i = 0; _i < 2; ++_i) \
        __builtin_amdgcn_global_load_lds((const unsigned*)((const char*)(gbase) + (voff)[_i]), (PG8_LAS unsigned*)(lds + (bufoff) + ldsw + _i * 8192), 16, 0, 0); } while (0)
#define PG8_LDA(dst, b, h) do { _Pragma("unroll") for (int m = 0; m < 4; ++m) _Pragma("unroll") for (int k = 0; k < 2; ++k) dst[m][k] = *(const PG8_LAS bf16x8*)(lds + PG8_SA(b, h) + aoff + m * 2048 + k * 1024); } while (0)
#define PG8_LDB(dst, b, h) do { _Pragma("unroll") for (int n = 0; n < 2; ++n) _Pragma("unroll") for (int k = 0; k < 2; ++k) dst[n][k] = *(const PG8_LAS bf16x8*)(lds + PG8_SB(b, h) + boff + n * 2048 + k * 1024); } while (0)
#define PG8_MMA(ai, bj, At, Bt) do { __builtin_amdgcn_s_setprio(1); _Pragma("unroll") for (int m = 0; m < 4; ++m) _Pragma("unroll") for (int n = 0; n < 2; ++n) _Pragma("unroll") for (int k = 0; k < 2; ++k) \
        acc[ai][bj][m][n] = __builtin_amdgcn_mfma_f32_16x16x32_bf16(Bt[n][k], At[m][k], acc[ai][bj][m][n], 0, 0, 0); __builtin_amdgcn_s_setprio(0); } while (0)
#define PG8_WAIT_V(n) asm volatile("s_waitcnt vmcnt(" #n ")" ::: "memory")
#define PG8_WAIT_L(n) asm volatile("s_waitcnt lgkmcnt(" #n ")" ::: "memory")
#define PG8_BAR __builtin_amdgcn_s_barrier()
#define PG8_SCHED __builtin_amdgcn_sched_barrier(0)
    Unit cur, nxt; int ui = 0;
    if (!S.next(0, cur)) return;
    f32x4 acc[2][2][4][2];
#pragma unroll
    for (int a = 0; a < 2; ++a)
#pragma unroll
        for (int b = 0; b < 2; ++b)
#pragma unroll
            for (int m = 0; m < 4; ++m)
#pragma unroll
                for (int n = 0; n < 2; ++n) acc[a][b][m][n] = (f32x4){0.f, 0.f, 0.f, 0.f};
    bf16x8 At[4][2], B0[2][2], B1[2][2];
    const char* cA = (const char*)g.A + (size_t)cur.pm * tstep; const char* cB = (const char*)g.Bt + (size_t)cur.pn * tstep;
    S.a_ready(cur);
    if constexpr (SP2) {
        PG8_STAGE(PG8_SB(0, 0), cB, voffB); PG8_STAGE(PG8_SB(0, 1), cB + hstep, voffB); PG8_STAGE(PG8_SA(0, 0), cA, voffA); PG8_STAGE(PG8_SA(0, 1), cA + hstep, voffA);
        if (wr == 1) PG8_BAR;
        PG8_WAIT_V(2); PG8_BAR;
        PG8_STAGE(PG8_SB(1, 0), cB + kstep, voffB); PG8_STAGE(PG8_SA(1, 0), cA + kstep, voffA); PG8_STAGE(PG8_SB(1, 1), cB + hstep + kstep, voffB);
        PG8_WAIT_V(6); PG8_BAR;
    } else {
        PG8_STAGE(PG8_SB(0, 0), cB, voffB); PG8_STAGE(PG8_SA(0, 0), cA, voffA); PG8_STAGE(PG8_SB(0, 1), cB + hstep, voffB); PG8_STAGE(PG8_SA(0, 1), cA + hstep, voffA);
        if (wr == 1) PG8_BAR;
        PG8_WAIT_V(4); PG8_BAR;
        PG8_STAGE(PG8_SB(1, 0), cB + kstep, voffB); PG8_STAGE(PG8_SA(1, 0), cA + kstep, voffA); PG8_STAGE(PG8_SB(1, 1), cB + hstep + kstep, voffB);
        PG8_WAIT_V(6); PG8_BAR;
    }
    for (;;) {
        const bool has_next = S.next(ui + 1, nxt);
        const char* nA = has_next ? (const char*)g.A + (size_t)nxt.pm * tstep : cA; const char* nB = has_next ? (const char*)g.Bt + (size_t)nxt.pn * tstep : cB;
        for (int t = 0; t < nt; t += 2) {
            const bool last = (t == nt - 2);
            const char* a1 = cA + (size_t)(t + 1) * kstep;
            const char* a2 = last ? nA : cA + (size_t)(t + 2) * kstep; const char* b2 = last ? nB : cB + (size_t)(t + 2) * kstep;
            const char* a3 = a2 + kstep; const char* b3 = b2 + kstep;
            if (last && has_next) S.a_ready(nxt);
            if constexpr (SP2) {
            PG8_LDB(B0, 0, 0); PG8_LDB(B1, 0, 1); PG8_SCHED; PG8_LDA(At, 0, 0); PG8_STAGE(PG8_SA(1, 1), a1 + hstep, voffA);
            PG8_WAIT_V(8); PG8_WAIT_L(0); PG8_BAR; PG8_MMA(0, 0, At, B0); PG8_MMA(0, 1, At, B1); PG8_BAR; PG8_SCHED;
            PG8_LDA(At, 0, 1); PG8_STAGE(PG8_SB(0, 0), b2, voffB); PG8_STAGE(PG8_SB(0, 1), b2 + hstep, voffB); PG8_STAGE(PG8_SA(0, 0), a2, voffA);
            PG8_WAIT_V(8); PG8_WAIT_L(0); PG8_BAR; PG8_MMA(1, 0, At, B0); PG8_MMA(1, 1, At, B1); PG8_BAR; PG8_SCHED;
            PG8_LDB(B0, 1, 0); PG8_LDB(B1, 1, 1); PG8_SCHED; PG8_LDA(At, 1, 0); PG8_STAGE(PG8_SA(0, 1), a2 + hstep, voffA);
            PG8_WAIT_V(8); PG8_WAIT_L(0); PG8_BAR; PG8_MMA(0, 0, At, B0); PG8_MMA(0, 1, At, B1); PG8_BAR; PG8_SCHED;
            PG8_LDA(At, 1, 1); PG8_STAGE(PG8_SB(1, 0), b3, voffB); PG8_STAGE(PG8_SB(1, 1), b3 + hstep, voffB); PG8_STAGE(PG8_SA(1, 0), a3, voffA);
            PG8_WAIT_V(8); PG8_WAIT_L(0); PG8_BAR; PG8_MMA(1, 0, At, B0); PG8_MMA(1, 1, At, B1); PG8_BAR; PG8_SCHED;
            } else {
            PG8_LDB(B0, 0, 0); PG8_SCHED; PG8_LDA(At, 0, 0); PG8_STAGE(PG8_SA(1, 1), a1 + hstep, voffA);
            PG8_WAIT_L(8); PG8_BAR; PG8_WAIT_L(0); PG8_MMA(0, 0, At, B0); PG8_BAR; PG8_SCHED;
            PG8_LDB(B1, 0, 1); PG8_STAGE(PG8_SB(0, 0), b2, voffB);
            PG8_BAR; PG8_WAIT_L(0); PG8_MMA(0, 1, At, B1); PG8_BAR;
            PG8_LDA(At, 0, 1); PG8_STAGE(PG8_SA(0, 0), a2, voffA);
            PG8_BAR; PG8_WAIT_L(0); PG8_MMA(1, 0, At, B0); PG8_BAR; PG8_SCHED;
            PG8_STAGE(PG8_SB(0, 1), b2 + hstep, voffB);
            PG8_WAIT_V(6); PG8_BAR; PG8_MMA(1, 1, At, B1); PG8_BAR;
            PG8_LDB(B0, 1, 0); PG8_SCHED; PG8_LDA(At, 1, 0); PG8_STAGE(PG8_SA(0, 1), a2 + hstep, voffA);
            PG8_WAIT_L(8); PG8_BAR; PG8_WAIT_L(0); PG8_MMA(0, 0, At, B0); PG8_BAR; PG8_SCHED;
            PG8_LDB(B1, 1, 1); PG8_STAGE(PG8_SB(1, 0), b3, voffB);
            PG8_BAR; PG8_WAIT_L(0); PG8_MMA(0, 1, At, B1); PG8_BAR;
            PG8_LDA(At, 1, 1); PG8_STAGE(PG8_SA(1, 0), a3, voffA);
            PG8_BAR; PG8_WAIT_L(0); PG8_MMA(1, 0, At, B0); PG8_BAR; PG8_SCHED;
            PG8_STAGE(PG8_SB(1, 1), b3 + hstep, voffB);
            PG8_WAIT_V(6); PG8_BAR; PG8_MMA(1, 1, At, B1); PG8_BAR;
            }
        }
        if constexpr (ALIGN_EPI) { if (wr == 0) PG8_BAR; }
        if constexpr (!Epi::AFTER_DRAIN) { E(acc, cur, wr, wc, fr, fq); S.done(cur); }
        if (!has_next) break;
#pragma unroll
        for (int a = 0; a < 2; ++a)
#pragma unroll
            for (int b = 0; b < 2; ++b)
#pragma unroll
                for (int m = 0; m < 4; ++m)
#pragma unroll
                    for (int n = 0; n < 2; ++n) acc[a][b][m][n] = (f32x4){0.f, 0.f, 0.f, 0.f};
        cur = nxt; cA = nA; cB = nB; ++ui;
        if constexpr (ALIGN_EPI) { if (wr == 1) PG8_BAR; }
    }
    PG8_WAIT_V(0);
    if constexpr (!ALIGN_EPI) { if (wr == 0) PG8_BAR; }
    PG8_BAR;
    if constexpr (Epi::AFTER_DRAIN) { E.fused(acc, cur, wr, wc, fr, fq, lds, wid, lane); S.done(cur); }
#undef PG8_SA
#undef PG8_SB
#undef PG8_STAGE
#undef PG8_LDA
#undef PG8_LDB
#undef PG8_MMA
#undef PG8_WAIT_V
#undef PG8_WAIT_L
#undef PG8_BAR
#undef PG8_SCHED
}
}
namespace pg8 {
constexpr int TP = 32768;
constexpr float RMS_EPS = 1e-6f;
typedef unsigned u32x2 __attribute__((ext_vector_type(2)));
__device__ __forceinline__ float quad_sum(float s) { s += __shfl_xor(s, 16); s += __shfl_xor(s, 32); return s; }
__device__ __forceinline__ float row_rstd(const float* ssq, int row, int fq) {
    const f32x4 p = *(const f32x4*)(ssq + (size_t)row * 16 + 4 * fq);
    const float s = quad_sum((p[0] + p[1]) + (p[2] + p[3]));
    return __builtin_amdgcn_rsqf(s * (1.0f / 1024.0f) + RMS_EPS);
}
__device__ __forceinline__ void rows_rstd(float (&rs)[2][4], const float* ssq, int rowb, int fq) {
#pragma unroll
    for (int ai = 0; ai < 2; ++ai) {
        f32x4 p[4];
#pragma unroll
        for (int m = 0; m < 4; ++m) p[m] = *(const f32x4*)(ssq + (size_t)(rowb + ai * HALF + m * 16) * 16 + 4 * fq);
#pragma unroll
        for (int m = 0; m < 4; ++m) { const float s = quad_sum((p[m][0] + p[m][1]) + (p[m][2] + p[m][3])); rs[ai][m] = __builtin_amdgcn_rsqf(s * (1.0f / 1024.0f) + RMS_EPS); }
        __builtin_amdgcn_sched_barrier(0);
    }
}
__device__ __forceinline__ void rows_rstd8(float (&rs)[2][4], const float* ssq, int rowb, int fq) {
    f32x4 p[2][4];
#pragma unroll
    for (int ai = 0; ai < 2; ++ai)
#pragma unroll
        for (int m = 0; m < 4; ++m) p[ai][m] = *(const f32x4*)(ssq + (size_t)(rowb + ai * HALF + m * 16) * 16 + 4 * fq);
#pragma unroll
    for (int ai = 0; ai < 2; ++ai)
#pragma unroll
        for (int m = 0; m < 4; ++m) { const float s = quad_sum((p[ai][m][0] + p[ai][m][1]) + (p[ai][m][2] + p[ai][m][3])); rs[ai][m] = __builtin_amdgcn_rsqf(s * (1.0f / 1024.0f) + RMS_EPS); }
}
__device__ __forceinline__ float gelu_tanh(float x) {
    const float y = 0.7978845608028654f * (x + 0.044715f * x * x * x);
    return x * __builtin_amdgcn_rcpf(1.0f + __builtin_amdgcn_exp2f(-2.8853900817779268f * y));
}
__device__ __forceinline__ u32x2 pack4(const f32x4 v) { u32x2 w; w.x = cvt_pk_bf16(v[0], v[1]); w.y = cvt_pk_bf16(v[2], v[3]); return w; }

struct EpiSguIn {
    static constexpr bool PERM = false, AFTER_DRAIN = false;
    const float* ssq; bf16_t* U; bf16_t* VP; float* vstat;
    __device__ __forceinline__ void operator()(const f32x4 (&acc)[2][2][4][2], const Unit& u, int wr, int wc, int fr, int fq) const {
        const bool isv = u.pn >= 4; bf16_t* O = isv ? +VP : +U; const int col0 = (u.pn & 3) * BM + wc * 32 + 4 * fq;
        float rsv[2][4]; rows_rstd8(rsv, ssq, u.pm * BM + wr * 64 + fr, fq);
#pragma unroll
        for (int ai = 0; ai < 2; ++ai)
#pragma unroll
            for (int m = 0; m < 4; ++m) {
                const int row = u.pm * BM + ai * HALF + wr * 64 + m * 16 + fr; const float rstd = rsv[ai][m];
                float s = 0.f, s2 = 0.f; bf16_t* rowp = O + (size_t)row * 1024 + col0;
#pragma unroll
                for (int bj = 0; bj < 2; ++bj)
#pragma unroll
                    for (int n = 0; n < 2; ++n) { f32x4 v = acc[ai][bj][m][n] * rstd;
                        v[0] = gelu_tanh(v[0]); v[1] = gelu_tanh(v[1]); v[2] = gelu_tanh(v[2]); v[3] = gelu_tanh(v[3]);
                        s += (v[0] + v[1]) + (v[2] + v[3]); s2 += (v[0] * v[0] + v[1] * v[1]) + (v[2] * v[2] + v[3] * v[3]);
                        *(u32x2*)(rowp + bj * HALF + n * 16) = pack4(v); }
                if (isv) { s = quad_sum(s); s2 = quad_sum(s2);
                    if (fq == 0) { float* p = vstat + ((size_t)row * 16 + (u.pn - 4) * 4 + wc) * 2; p[0] = s; p[1] = s2; } }
            }
    }
};
__device__ __forceinline__ void part_arrive(unsigned* ctr, int tid) {
    asm volatile("s_waitcnt vmcnt(0)" ::: "memory"); __syncthreads();
    if (__builtin_amdgcn_readfirstlane(tid >> 6) == 0) { __builtin_amdgcn_fence(__ATOMIC_RELEASE, "agent"); asm volatile("s_waitcnt vmcnt(0)" ::: "memory");
        __hip_atomic_fetch_add(ctr, (tid & 63) == 0 ? 1u : 0u, __ATOMIC_RELAXED, __HIP_MEMORY_SCOPE_AGENT); }
}
__device__ __forceinline__ void part_wait(unsigned* ctr, unsigned need, int tid) {
    if (__builtin_amdgcn_readfirstlane(tid >> 6) == 0) {
        while ((unsigned)__builtin_amdgcn_readfirstlane((int)__hip_atomic_load(ctr, __ATOMIC_RELAXED, __HIP_MEMORY_SCOPE_AGENT)) < need) __builtin_amdgcn_s_sleep(2);
        __builtin_amdgcn_fence(__ATOMIC_ACQUIRE, "agent"); asm volatile("s_waitcnt vmcnt(0)" ::: "memory"); }
    __syncthreads();
}
struct EpiPart {
    static constexpr bool PERM = true, AFTER_DRAIN = false;
    float* part; unsigned* ctr;
    __device__ __forceinline__ void operator()(const f32x4 (&acc)[2][2][4][2], const Unit&, int wr, int wc, int fr, int fq) const {
        const int tid = ((wr * 4 + wc) << 6) | (fq * 16 + fr); f32x4* p = (f32x4*)part + tid;
#pragma unroll
        for (int ai = 0; ai < 2; ++ai)
#pragma unroll
            for (int bj = 0; bj < 2; ++bj)
#pragma unroll
                for (int m = 0; m < 4; ++m)
#pragma unroll
                    for (int n = 0; n < 2; ++n) p[(((ai * 2 + bj) * 4 + m) * 2 + n) * 512] = acc[ai][bj][m][n];
        part_arrive(ctr, tid);
    }
};
__device__ __forceinline__ void add_partials(const f32x4 (&acc)[2][2][4][2], const float* part, unsigned* ctr, int wr, int wc, int fr, int fq) {
    const int tid = ((wr * 4 + wc) << 6) | (fq * 16 + fr); part_wait(ctr, 3u, tid); asm volatile("" ::: "memory"); __builtin_amdgcn_sched_barrier(0);
    f32x4 (&ac)[2][2][4][2] = const_cast<f32x4 (&)[2][2][4][2]>(acc);
#pragma unroll 1
    for (int pk = 2; pk >= 0; --pk) {
        const f32x4* p = (const f32x4*)part + (size_t)pk * 16384 + tid;
#pragma unroll
        for (int ai = 0; ai < 2; ++ai)
#pragma unroll
            for (int bj = 0; bj < 2; ++bj)
#pragma unroll
                for (int m = 0; m < 4; ++m)
#pragma unroll
                    for (int n = 0; n < 2; ++n) { ac[ai][bj][m][n] = p[(((ai * 2 + bj) * 4 + m) * 2 + n) * 512] + ac[ai][bj][m][n];
                        if (n == 1 && (m & 1)) { asm volatile("" : "+v"(ac[ai][bj][m - 1][0]), "+v"(ac[ai][bj][m - 1][1]), "+v"(ac[ai][bj][m][0]), "+v"(ac[ai][bj][m][1]) :: "memory"); __builtin_amdgcn_sched_barrier(0); } }
    }
}
template <bool FINAL, bool PART = false> struct EpiRes {
    static constexpr bool PERM = true, AFTER_DRAIN = false;
    const bf16_t* hin; bf16_t* hb; float* ssq; float* yout;
    const float* part; unsigned* ctr;
    __device__ __forceinline__ void operator()(const f32x4 (&acc)[2][2][4][2], const Unit& u, int wr, int wc, int fr, int fq) const {
        if constexpr (PART) add_partials(acc, part, ctr, wr, wc, fr, fq);
        const int col0 = u.pn * BM + wc * 32 + 8 * fq, rowb = u.pm * BM + wr * 64 + fr;
        u32x4 pre[3][2];
#define EPIRES_LOAD(g, buf) do { const bf16_t* hi_ = hin + (size_t)(rowb + ((g) >> 2) * HALF + ((g) & 3) * 16) * 1024 + col0; \
            pre[buf][0] = *(const u32x4*)(hi_); pre[buf][1] = *(const u32x4*)(hi_ + HALF); } while (0)
        EPIRES_LOAD(0, 0); EPIRES_LOAD(1, 1);
#pragma unroll
        for (int g = 0; g < 8; ++g) {
            if (g + 2 < 8) EPIRES_LOAD(g + 2, (g + 2) % 3);
            const int ai = g >> 2, m = g & 3, row = rowb + ai * HALF + m * 16; float s2 = 0.f;
#pragma unroll
            for (int bj = 0; bj < 2; ++bj) { const u32x4 r = pre[g % 3][bj];
                const f32x4 v0 = acc[ai][bj][m][0] + (f32x4){__uint_as_float(r.x << 16), __uint_as_float(r.x & 0xffff0000u), __uint_as_float(r.y << 16), __uint_as_float(r.y & 0xffff0000u)};
                const f32x4 v1 = acc[ai][bj][m][1] + (f32x4){__uint_as_float(r.z << 16), __uint_as_float(r.z & 0xffff0000u), __uint_as_float(r.w << 16), __uint_as_float(r.w & 0xffff0000u)};
                if (FINAL) { float* yo = yout + (size_t)row * 1024 + col0 + bj * HALF; __builtin_nontemporal_store(v0, (f32x4*)yo); __builtin_nontemporal_store(v1, (f32x4*)(yo + 4)); }
                else { u32x4 w; w.x = cvt_pk_bf16(v0[0], v0[1]); w.y = cvt_pk_bf16(v0[2], v0[3]); w.z = cvt_pk_bf16(v1[0], v1[1]); w.w = cvt_pk_bf16(v1[2], v1[3]);
                    *(u32x4*)(hb + (size_t)row * 1024 + col0 + bj * HALF) = w;
                    s2 += ((v0[0] * v0[0] + v0[1] * v0[1]) + (v0[2] * v0[2] + v0[3] * v0[3])) + ((v1[0] * v1[0] + v1[1] * v1[1]) + (v1[2] * v1[2] + v1[3] * v1[3])); } }
            if (!FINAL) { s2 = quad_sum(s2); if (fq == 0) ssq[(size_t)row * 16 + u.pn * 4 + wc] = s2; }
        }
#undef EPIRES_LOAD
    }
};
template <int S> __device__ __forceinline__ float dpp_prev(float prevm, float cur) {
    const int o = __builtin_amdgcn_update_dpp(0, __builtin_bit_cast(int, prevm), 0x120 + S, 0xf, 0xf, true);
    return __builtin_bit_cast(float, __builtin_amdgcn_update_dpp(o, __builtin_bit_cast(int, cur), 0x110 + S, 0xf, 0xf, false));
}
template <int S> __device__ __forceinline__ float dpp_first(float cur) {
    return __builtin_bit_cast(float, __builtin_amdgcn_update_dpp(0, __builtin_bit_cast(int, cur), 0x110 + S, 0xf, 0xf, true));
}
template <bool SAMPLE> struct EpiUp {
    static constexpr bool PERM = false, AFTER_DRAIN = false;
    const float* ssq; bf16_t* A; bf16_t* Gout; float* stash; float* convP; float* convS; const float* cw; const float* cb;
    __device__ __forceinline__ void operator()(const f32x4 (&acc)[2][2][4][2], const Unit& u, int wr, int wc, int fr, int fq) const {
        float rsv[2][4]; if constexpr (SAMPLE) rows_rstd8(rsv, ssq, u.pm * BM + wr * 64 + fr, fq); else rows_rstd(rsv, ssq, u.pm * BM + wr * 64 + fr, fq);
        const int cbase = u.pn * 128 + wc * 32 + 4 * fq;
        if constexpr (SAMPLE) {
#pragma unroll
            for (int ai = 0; ai < 2; ++ai)
#pragma unroll
                for (int m = 0; m < 4; ++m) {
                    const int row = u.pm * BM + ai * HALF + wr * 64 + m * 16 + fr; const float rstd = rsv[ai][m];
                    float* tp = nullptr; { const int rs = row - TP, t = rs & 31; if (t >= 30) tp = convS + (size_t)((rs >> 5) * 2 + (t - 30)) * 5632; }
                    bf16_t* ap = A + (size_t)row * 5632;
#pragma unroll
                    for (int bj = 0; bj < 2; ++bj)
#pragma unroll
                        for (int n = 0; n < 2; ++n) { const f32x4 v = acc[ai][bj][m][n] * rstd; const int cl = bj * 2816 + cbase + 16 * n; *(u32x2*)(ap + cl) = pack4(v);
                            if (tp) *(f32x4*)(tp + cl) = v; }
                }
        } else {
        typedef float f32x2v __attribute__((ext_vector_type(2)));
        f32x2v wc_[8], wn_[8];
#define UPW_LOAD(dst, gi_) do { const int Jh_ = cbase + 16 * ((gi_) >> 1) + 2 * ((gi_) & 1); \
            dst[0] = *(const f32x2v*)(cw + Jh_); dst[1] = *(const f32x2v*)(cw + 5632 + Jh_); dst[2] = *(const f32x2v*)(cw + 2 * 5632 + Jh_); dst[3] = *(const f32x2v*)(cb + Jh_); \
            dst[4] = *(const f32x2v*)(cw + 2816 + Jh_); dst[5] = *(const f32x2v*)(cw + 5632 + 2816 + Jh_); dst[6] = *(const f32x2v*)(cw + 2 * 5632 + 2816 + Jh_); dst[7] = *(const f32x2v*)(cb + 2816 + Jh_); } while (0)
        UPW_LOAD(wc_, 0);
        f32x4 (&ac)[2][2][4][2] = const_cast<f32x4 (&)[2][2][4][2]>(acc);
#pragma unroll
        for (int ai = 0; ai < 2; ++ai)
#pragma unroll
            for (int m = 0; m < 4; ++m)
#pragma unroll
                for (int bj = 0; bj < 2; ++bj)
#pragma unroll
                    for (int n = 0; n < 2; ++n) ac[ai][bj][m][n] = ac[ai][bj][m][n] * rsv[ai][m];
        asm volatile("" ::: "memory"); __builtin_amdgcn_sched_barrier(0);
        unsigned pk0[2][4];
#pragma unroll
        for (int gi = 0; gi < 4; ++gi) {
            const int n = gi >> 1, jh = gi & 1, J = cbase + 16 * n;
            const f32x2v w0g = wc_[0], w1g = wc_[1], w2g = wc_[2], bg = wc_[3], w0v = wc_[4], w1v = wc_[5], w2v = wc_[6], bv = wc_[7];
#pragma unroll
            for (int ai = 0; ai < 2; ++ai) {
                if (ai == 1 && gi < 3) UPW_LOAD(wn_, gi + 1);
#pragma unroll
                for (int m = 0; m < 4; ++m) {
                    const int row = u.pm * BM + ai * HALF + wr * 64 + m * 16 + fr;
                    float og[2];
#pragma unroll
                    for (int e = 0; e < 2; ++e) {
                        const float xg = ac[ai][0][m][n][2 * jh + e], xv = ac[ai][1][m][n][2 * jh + e];
                        float g1, g2, v1, v2;
                        if (m == 0) { g1 = dpp_first<1>(xg); g2 = dpp_first<2>(xg); v1 = dpp_first<1>(xv); v2 = dpp_first<2>(xv); }
                        else { const float pg = ac[ai][0][m ? m - 1 : 0][n][2 * jh + e], pv = ac[ai][1][m ? m - 1 : 0][n][2 * jh + e];
                            g1 = dpp_prev<1>(pg, xg); g2 = dpp_prev<2>(pg, xg); v1 = dpp_prev<1>(pv, xv); v2 = dpp_prev<2>(pv, xv); }
                        const float cg = xg * w2g[e] + g1 * w1g[e] + g2 * w0g[e] + bg[e], cv = xv * w2v[e] + v1 * w1v[e] + v2 * w0v[e] + bv[e];
                        og[e] = cg * __builtin_amdgcn_rcpf(1.0f + __builtin_amdgcn_exp2f(-1.4426950408889634f * cg)) * cv;
                    }
                    const unsigned pk = cvt_pk_bf16(og[0], og[1]);
                    if (jh == 0) pk0[ai][m] = pk;
                    else {
                        if (!(m == 0 && fr < 2)) { u32x2 w; w.x = pk0[ai][m]; w.y = pk; *(u32x2*)(Gout + (size_t)row * 2816 + J) = w; }
                        if ((m == 0 && fr < 2) || (m == 3 && fr >= 14)) {
                            const f32x4 xg4 = ac[ai][0][m][n], xv4 = ac[ai][1][m][n];
                            float* sp = stash + (((size_t)(row >> 6) * 4 + (m == 0 ? fr : fr - 12)) * 2) * 2816 + J; *(f32x4*)sp = xg4; *(f32x4*)(sp + 2816) = xv4;
                            if (m == 3 && (row & 8191) >= 8190) { float* tp = convP + (size_t)((row >> 13) * 2 + ((row & 8191) - 8190)) * 5632; *(f32x4*)(tp + J) = xg4; *(f32x4*)(tp + 2816 + J) = xv4; } }
                    }
                    asm volatile("" ::: "memory"); __builtin_amdgcn_sched_barrier(0);
                }
            }
#pragma unroll
            for (int k = 0; k < 8; ++k) wc_[k] = wn_[k];
        }
#undef UPW_LOAD
        }
    }
};
struct EpiQKV {
    static constexpr bool PERM = false, AFTER_DRAIN = false;
    const float* ssq; bf16_t* Q; bf16_t* K; bf16_t* V; float* koP; float* koS; float* voP; float* voS; const float* qg; const float* kg; float c2;
    __device__ __forceinline__ void operator()(const f32x4 (&acc)[2][2][4][2], const Unit& u, int wr, int wc, int fr, int fq) const {
        const int t = u.pn >> 2, head = (u.pn & 3) * 4 + wc, colh = head * 64 + 4 * fq;
        const float* qg_ = qg; const float* kg_ = kg; bf16_t* Q_ = Q; bf16_t* K_ = K; bf16_t* V_ = V;
        asm volatile("" : "+s"(qg_), "+s"(kg_), "+s"(Q_), "+s"(K_), "+s"(V_));
        f32x4 gv[2][2];
#pragma unroll
        for (int bj = 0; bj < 2; ++bj)
#pragma unroll
            for (int n = 0; n < 2; ++n) gv[bj][n] = (t < 2) ? *(const f32x4*)((t == 0 ? qg_ : kg_) + 32 * bj + 16 * n + 4 * fq) : (f32x4){1.f, 1.f, 1.f, 1.f};
        bf16_t* B = t == 0 ? Q_ : (t == 1 ? K_ : V_);
        float rsv[2][4]; rows_rstd8(rsv, ssq, u.pm * BM + wr * 64 + fr, fq);
#pragma unroll
        for (int ai = 0; ai < 2; ++ai)
#pragma unroll
            for (int m = 0; m < 4; ++m) {
                const int row = u.pm * BM + ai * HALF + wr * 64 + m * 16 + fr; const float rstd = rsv[ai][m];
                f32x4 v[2][2]; float ss = 0.f;
#pragma unroll
                for (int bj = 0; bj < 2; ++bj)
#pragma unroll
                    for (int n = 0; n < 2; ++n) { v[bj][n] = acc[ai][bj][m][n] * rstd; const f32x4 x = v[bj][n]; ss += (x[0] * x[0] + x[1] * x[1]) + (x[2] * x[2] + x[3] * x[3]); }
                float rs = 1.f;
                if (t < 2) { ss = quad_sum(ss); rs = __builtin_amdgcn_rsqf(ss * (1.0f / 64.0f) + RMS_EPS); if (t == 0) rs *= c2; }
                float* fo = nullptr;
                if (t == 1) fo = (row < TP ? koP + (size_t)row * 1024 : koS + (size_t)(row - TP) * 1024) + colh;
                if (t == 2) fo = (row < TP ? voP + (size_t)row * 1024 : voS + (size_t)(row - TP) * 1024) + colh;
                bf16_t* bo = B + (size_t)row * 1024 + colh;
#pragma unroll
                for (int bj = 0; bj < 2; ++bj)
#pragma unroll
                    for (int n = 0; n < 2; ++n) { const f32x4 o = v[bj][n] * rs * gv[bj][n]; *(u32x2*)(bo + 32 * bj + 16 * n) = pack4(o);
                        if (fo) __builtin_nontemporal_store(o, (f32x4*)(fo + 32 * bj + 16 * n)); }
            }
    }
};
struct OneUnit { int pm, pn;
    __device__ __forceinline__ bool next(int i, Unit& u) const { if (i != 0) return false; u.pm = pm; u.pn = pn; return true; }
    __device__ __forceinline__ void a_ready(const Unit&) const {}
    __device__ __forceinline__ void done(const Unit&) const {}
};
}
#include <hip/hip_bf16.h>
#include <cmath>
namespace attn_body {
using bf16=__hip_bfloat16;
using bf16x8=__attribute__((ext_vector_type(8)))short;
using s16x4=__attribute__((ext_vector_type(4)))short;
using f32x16=__attribute__((ext_vector_type(16)))float;
using u32x4=__attribute__((ext_vector_type(4)))unsigned;
constexpr int BATCH=4,NHEAD=16,SEQ=8192,D=64,DM=NHEAD*D;
constexpr int NW=8,QBLK=32,QB=QBLK*NW,KVBLK=64,NQB=SEQ/QB;
constexpr int ATTN_PITCH=DM, ATTN_UNIT_ROWS=QB;
__device__ __forceinline__ int crow(int r,int hi){return (r&3)+8*(r>>2)+4*hi;}
#define SBAR() __builtin_amdgcn_sched_barrier(0)
__device__ __forceinline__ void cmask(f32x16&p0,f32x16&p1,int jb,int qrel,int hi){
  const float NEG=-INFINITY; int kb=64*jb+4*hi;
  #pragma unroll
  for(int r=0;r<16;++r){int kv=kb+(r&3)+8*(r>>2); if(kv>qrel)p0[r]=NEG; if(kv+32>qrel)p1[r]=NEG;}
}

constexpr int NSLOT=3, SLOTB=8192, LDS_BIAS=86016;
constexpr int LDS_K=0, LDS_V=NSLOT*SLOTB, LDS_WS=2*NSLOT*SLOTB, LDS_OST=LDS_WS+NW*64*4, LDS_BYTES=LDS_OST+NW*4096;
constexpr float C2=0.125f*1.4426950408889634f;
__device__ __forceinline__ void glds16(const void*gsrc,unsigned lds_dst){unsigned keep;
  asm volatile("s_mov_b32 %0, m0\n\ts_mov_b32 m0, %2\n\ts_nop 0\n\tglobal_load_lds_dwordx4 %1, off\n\ts_mov_b32 m0, %0":"=&s"(keep):"v"(gsrc),"s"(lds_dst):"memory");}
__device__ __forceinline__ float max3f(float a,float b,float c){float r;asm("v_max3_f32 %0, %1, %2, %3":"=v"(r):"v"(a),"v"(b),"v"(c));return r;}
__device__ __forceinline__ float max2f(float a,float b){float r;asm("v_max_f32_e32 %0, %1, %2":"=v"(r):"v"(a),"v"(b));return r;}
__device__ __forceinline__ float fadd_s(float a,float b){float r;asm("v_add_f32_e32 %0, %1, %2":"=v"(r):"v"(a),"v"(b));return r;}
__device__ __forceinline__ float fsub_s(float a,float b){float r;asm("v_sub_f32_e32 %0, %1, %2":"=v"(r):"v"(a),"v"(b));return r;}
typedef float f32x2_t __attribute__((ext_vector_type(2))); typedef __bf16 bf16x2_t __attribute__((ext_vector_type(2)));
__device__ __forceinline__ unsigned cvtpk_s(float lo,float hi){f32x2_t v={lo,hi};bf16x2_t b=__builtin_convertvector(v,bf16x2_t);return __builtin_bit_cast(unsigned,b);}
#define WAIT_BAR(N) asm volatile("s_waitcnt vmcnt(" #N ") lgkmcnt(0)\n\ts_barrier":::"memory")

__device__ __forceinline__ void qkt(f32x16&p0,f32x16&p1,const char*Kslot,const bf16x8*qr,int r32,int hi){
  const char*kb=Kslot+hi*1024+r32*16;
  #pragma unroll
  for(int d0=0;d0<4;++d0){
    const bf16x8 b0=*reinterpret_cast<const bf16x8*>(kb+d0*2048);
    const bf16x8 b1=*reinterpret_cast<const bf16x8*>(kb+d0*2048+512);
    if(d0==0){p0=__builtin_amdgcn_mfma_f32_32x32x16_bf16(b0,qr[0],p0,0,0,0);p1=__builtin_amdgcn_mfma_f32_32x32x16_bf16(b1,qr[0],p1,0,0,0);}
    else{p0=__builtin_amdgcn_mfma_f32_32x32x16_bf16(b0,qr[d0],p0,0,0,0);p1=__builtin_amdgcn_mfma_f32_32x32x16_bf16(b1,qr[d0],p1,0,0,0);}}
}
typedef __attribute__((address_space(3))) const char* lds_cptr;
typedef short v4i16_t __attribute__((ext_vector_type(4)));
__device__ __forceinline__ void kload8(bf16x8*kf,lds_cptr kp){
  kf[0]=*(const __attribute__((address_space(3))) bf16x8*)(kp);      kf[1]=*(const __attribute__((address_space(3))) bf16x8*)(kp+512);
  kf[2]=*(const __attribute__((address_space(3))) bf16x8*)(kp+2048); kf[3]=*(const __attribute__((address_space(3))) bf16x8*)(kp+2560);
  kf[4]=*(const __attribute__((address_space(3))) bf16x8*)(kp+4096); kf[5]=*(const __attribute__((address_space(3))) bf16x8*)(kp+4608);
  kf[6]=*(const __attribute__((address_space(3))) bf16x8*)(kp+6144); kf[7]=*(const __attribute__((address_space(3))) bf16x8*)(kp+6656);
}
__device__ __forceinline__ void kload2(bf16x8*kf,lds_cptr kp,int j){ kf[2*j]=*(const __attribute__((address_space(3))) bf16x8*)(kp+j*2048); kf[2*j+1]=*(const __attribute__((address_space(3))) bf16x8*)(kp+j*2048+512); }
__device__ __forceinline__ s16x4 vtr(lds_cptr p){ return __builtin_bit_cast(s16x4,__builtin_amdgcn_ds_read_tr16_b64_v4i16((__attribute__((address_space(3))) v4i16_t*)p)); }
__device__ __forceinline__ float rowmax(const f32x16&p0,const f32x16&p1){
  float a=max3f(p0[0],p0[1],p1[0]),b=max3f(p0[2],p0[3],p1[1]);a=max3f(a,p1[2],p1[3]);
  #pragma unroll
  for(int r=4;r<16;r+=4){a=max3f(a,p0[r],p0[r+1]);b=max3f(b,p0[r+2],p0[r+3]);a=max3f(a,p1[r],p1[r+1]);b=max3f(b,p1[r+2],p1[r+3]);}
  const float m=max2f(a,b);
  auto rr=__builtin_amdgcn_permlane32_swap(__float_as_uint(m),__float_as_uint(m),false,false);
  return max2f(__uint_as_float(rr[0]),__uint_as_float(rr[1]));
}
__device__ __forceinline__ void pv(f32x16*o,int vb,bf16x8 pa0,bf16x8 pa1,bf16x8 pa2,bf16x8 pa3){
  #pragma unroll
  for(int d0=0;d0<2;++d0){s16x4 lo[4],hi[4];
    #pragma unroll
    for(int ks=0;ks<4;++ks){
      asm volatile("ds_read_b64_tr_b16 %0,%1 offset:%c2":"=&v"(lo[ks]):"v"(vb),"i"(d0*4096+ks*1024):"memory");
      asm volatile("ds_read_b64_tr_b16 %0,%1 offset:%c2":"=&v"(hi[ks]):"v"(vb),"i"(d0*4096+ks*1024+512):"memory");}
    asm volatile("s_waitcnt lgkmcnt(0)":::"memory");SBAR();
    #define PK(k) (bf16x8){lo[k][0],lo[k][1],lo[k][2],lo[k][3],hi[k][0],hi[k][1],hi[k][2],hi[k][3]}
    o[d0]=__builtin_amdgcn_mfma_f32_32x32x16_bf16(pa0,PK(0),o[d0],0,0,0);
    o[d0]=__builtin_amdgcn_mfma_f32_32x32x16_bf16(pa1,PK(1),o[d0],0,0,0);
    o[d0]=__builtin_amdgcn_mfma_f32_32x32x16_bf16(pa2,PK(2),o[d0],0,0,0);
    o[d0]=__builtin_amdgcn_mfma_f32_32x32x16_bf16(pa3,PK(3),o[d0],0,0,0);
    #undef PK
  }
}

#ifndef ATTN_STORE16
#define ATTN_STORE16(p,v) (*(u32x4*)(p)=(v))
#endif
template<int THRL> __device__ __forceinline__ void attn_unit(int wv0,int b,int h,int qb,int kt0,const bf16*Q,const bf16*__restrict__ K,const bf16*__restrict__ V,bf16*O,char*shm){
  int tid_=(wv0<<6)|(int)__builtin_amdgcn_mbcnt_hi(~0u,__builtin_amdgcn_mbcnt_lo(~0u,0u)); asm volatile("":"+v"(tid_)); const int tid=tid_,lane=tid&63,r32=lane&31,hi=lane>>5; const int wid=__builtin_amdgcn_readfirstlane(tid>>6);
  const long rowbase=(long)b*SEQ; const int q0=qb*QB;
  const bf16*Qw=Q+(rowbase+q0+wid*QBLK)*DM+h*D;
  const bf16*Kh=K+(rowbase+(long)kt0*KVBLK)*DM+h*D,*Vh=V+(rowbase+(long)kt0*KVBLK)*DM+h*D;
  const unsigned lds0=(unsigned)(uintptr_t)shm;
  float*wsf=(float*)(shm+LDS_WS)+wid*64;
  const bf16*ksrc=Kh+(long)lane*DM+wid*8;
  const bf16*vsrc=Vh+(long)(16*(wid&3)+(lane>>2))*DM+(wid>>2)*32+(lane&3)*8;
  const unsigned kdst=lds0+LDS_K+wid*1024, vdst=lds0+LDS_V+wid*1024;
  #define DMA_K(t,slot) glds16(ksrc+(long)(t)*KVBLK*DM,(unsigned)__builtin_amdgcn_readfirstlane(kdst+(slot)))
  #define DMA_V(t,slot) glds16(vsrc+(long)(t)*KVBLK*DM,(unsigned)__builtin_amdgcn_readfirstlane(vdst+(slot)))
  const int vb0=(int)(lds0+LDS_V)+((lane>>4)&1)*32+(lane&3)*8+(4*hi+((lane&15)>>2))*64;
  const char*Kbase=shm+LDS_K; bf16x8 kf[8];
  const lds_cptr shm3=(lds_cptr)shm; const lds_cptr kp0=shm3+LDS_K+hi*1024+r32*16; const lds_cptr vp0=shm3+LDS_V+((lane>>4)&1)*32+(lane&3)*8+(4*hi+((lane&15)>>2))*64;
  const int NT=(q0+QB)/KVBLK-kt0;
  DMA_K(0,0);DMA_V(0,0);DMA_K(1,SLOTB);
  bf16x8 qr[4];
  #pragma unroll
  for(int d0=0;d0<4;++d0)qr[d0]=*reinterpret_cast<const bf16x8*>(&Qw[(long)r32*DM+d0*16+hi*8]);
  float mhat=0.f,l_reg=0.f;f32x16 o[2];o[0]=f32x16{};o[1]=f32x16{};
  typedef float f32x4v __attribute__((ext_vector_type(4))); typedef __attribute__((address_space(3))) const f32x4v* lds_f4p;
  const lds_f4p bias4=(lds_f4p)((__attribute__((address_space(3))) const char*)shm+LDS_BIAS)+hi+(kt0)*16;
  #define CINIT(C0,C1,t) do{ const lds_f4p bp_=bias4+(t)*16; \
    _Pragma("unroll") for(int g_=0;g_<4;++g_){ const f32x4v x_=bp_[2*g_], y_=bp_[8+2*g_]; \
      C0[4*g_]=x_[0]-mhat; C0[4*g_+1]=x_[1]-mhat; C0[4*g_+2]=x_[2]-mhat; C0[4*g_+3]=x_[3]-mhat; \
      C1[4*g_]=y_[0]-mhat; C1[4*g_+1]=y_[1]-mhat; C1[4*g_+2]=y_[2]-mhat; C1[4*g_+3]=y_[3]-mhat; } }while(0)

  const int qrel=wid*QBLK+r32;
  #define CMASK(P0,P1,t) do{int jb_=(t)-(NT-4); if(jb_>=0)cmask(P0,P1,jb_,qrel,hi);}while(0)
  bool resc=false;
  #define START(P0,P1) do{ const float rm=rowmax(P0,P1); resc=false; \
    { const float dl=rm; mhat=fadd_s(mhat,dl); \
      _Pragma("unroll") for(int r=0;r<16;++r){P0[r]=fsub_s(P0[r],dl);P1[r]=fsub_s(P1[r],dl);} \
       } \
    _Pragma("unroll") for(int r=0;r<16;++r)P0[r]=__builtin_amdgcn_exp2f(P0[r]); }while(0)
  #define RESC() do{ if(resc){ asm volatile("s_waitcnt lgkmcnt(0)":::"memory"); \
      _Pragma("unroll") for(int d_=0;d_<2;++d_) _Pragma("unroll") for(int r=0;r<16;++r)o[d_][r]*=wsf[crow(r,hi)]; } }while(0)
  f32x16 pA0,pA1,pB0,pB1;
  int sl_prev=0,sl_cur=0,sl_next=SLOTB;
  #define ROT() do{sl_prev=sl_cur;sl_cur=sl_next;sl_next=(sl_next==(NSLOT-1)*SLOTB)?0:sl_next+SLOTB;}while(0)
  DMA_K(2,2*SLOTB);
  WAIT_BAR(3);
  CINIT(pA0,pA1,0); qkt(pA0,pA1,Kbase,qr,r32,hi);asm volatile("s_nop 15\n\ts_nop 7":"+v"(pA0),"+v"(pA1));CMASK(pA0,pA1,0);
  START(pA0,pA1);
  _Pragma("unroll") for(int r=0;r<16;++r)pA1[r]=__builtin_amdgcn_exp2f(pA1[r]);
  WAIT_BAR(0);
  DMA_K(3,0);DMA_V(1,SLOTB);
  ROT();
  kload8(kf,kp0+sl_cur);
  WAIT_BAR(2);
  s16x4 vlo[8],vhi[8]; u32x4 pw0,pw1,pw2,pw3;
  #define PKW(P,B) cvtpk_s(P[B],P[B+1])
  #define PAF(k) __builtin_bit_cast(bf16x8,pw##k)
  #define VFR(i) (bf16x8){vlo[i][0],vlo[i][1],vlo[i][2],vlo[i][3],vhi[i][0],vhi[i][1],vhi[i][2],vhi[i][3]}
  #define PIN(x) asm volatile("":"+v"(x))
  #define MX3(a,b,c) __builtin_fmaxf(__builtin_fmaxf((a),(b)),(c))
  #define GAPA(MF,A0,A1,A2,A3,W0,W1,PW) do{ MF; sacc+=A0; sacc+=A1; sacc+=A2; sacc+=A3; PIN(sacc); W0; W1; PIN(PW); SBAR(); }while(0)
  #define EX(v) __builtin_amdgcn_exp2f(v)
  #define GAPB(MF,X,B) do{ MF; X[B]=EX(X[B]); X[B+1]=EX(X[B+1]); X[B+2]=EX(X[B+2]); X[B+3]=EX(X[B+3]); PIN(X); SBAR(); }while(0)
  #define VRD(i) do{ vlo[i]=vtr(vp_+(((i)>>2)*4096+((i)&3)*1024)); vhi[i]=vtr(vp_+(((i)>>2)*4096+((i)&3)*1024+512)); }while(0)
  #define KRD(G,j) do{ if(G){ kload2(kf,kp0+sl_next,j); SBAR(); } }while(0)
  #define STEP(C0,C1,P0,P1,t,GK,GV,GL) do{ SBAR(); CINIT(C0,C1,t); SBAR(); \
    const lds_cptr vp_=vp0+sl_prev; \
    VRD(0); SBAR(); float sacc=(P0[0]+P0[1]); \
    GAPA(C0=__builtin_amdgcn_mfma_f32_32x32x16_bf16(kf[0],qr[0],C0,0,0,0), P0[2],P0[3],P0[4],P0[5],     pw0[0]=PKW(P0,0), pw0[1]=PKW(P0,2), pw0); \
    VRD(4); SBAR(); GAPA(C1=__builtin_amdgcn_mfma_f32_32x32x16_bf16(kf[1],qr[0],C1,0,0,0), P0[6],P0[7],P0[8],P0[9],     pw0[2]=PKW(P0,4), pw0[3]=PKW(P0,6), pw0); \
    VRD(1); SBAR(); GAPA(C0=__builtin_amdgcn_mfma_f32_32x32x16_bf16(kf[2],qr[1],C0,0,0,0),   P0[10],P0[11],P0[12],P0[13], pw1[0]=PKW(P0,8), pw1[1]=PKW(P0,10), pw1); \
    VRD(5); SBAR(); GAPA(C1=__builtin_amdgcn_mfma_f32_32x32x16_bf16(kf[3],qr[1],C1,0,0,0),   P0[14],P0[15],P1[0],P1[1],   pw1[2]=PKW(P0,12),pw1[3]=PKW(P0,14), pw1); \
    VRD(2); SBAR(); GAPA(C0=__builtin_amdgcn_mfma_f32_32x32x16_bf16(kf[4],qr[2],C0,0,0,0),   P1[2],P1[3],P1[4],P1[5],     pw2[0]=PKW(P1,0), pw2[1]=PKW(P1,2), pw2); \
    VRD(6); SBAR(); GAPA(C1=__builtin_amdgcn_mfma_f32_32x32x16_bf16(kf[5],qr[2],C1,0,0,0),   P1[6],P1[7],P1[8],P1[9],     pw2[2]=PKW(P1,4), pw2[3]=PKW(P1,6), pw2); \
    VRD(3); SBAR(); GAPA(C0=__builtin_amdgcn_mfma_f32_32x32x16_bf16(kf[6],qr[3],C0,0,0,0),   P1[10],P1[11],P1[12],P1[13], pw3[0]=PKW(P1,8), pw3[1]=PKW(P1,10), pw3); \
    VRD(7); SBAR(); GAPA(C1=__builtin_amdgcn_mfma_f32_32x32x16_bf16(kf[7],qr[3],C1,0,0,0),   P1[14],P1[15],0.f,0.f,       pw3[2]=PKW(P1,12),pw3[3]=PKW(P1,14), pw3); \
    l_reg+=sacc; \
    if(GK){DMA_K((t)+3,sl_cur);} if(GV){DMA_V((t)+1,sl_next);} \
    CMASK(C0,C1,t); \
    { float a=MX3(C0[0],C0[1],C1[0]),b=MX3(C0[2],C0[3],C1[1]); a=MX3(a,C1[2],C1[3]); \
      _Pragma("unroll") for(int r=4;r<16;r+=4){a=MX3(a,C0[r],C0[r+1]);b=MX3(b,C0[r+2],C0[r+3]);a=MX3(a,C1[r],C1[r+1]);b=MX3(b,C1[r+2],C1[r+3]);} \
      float rm=__builtin_fmaxf(a,b); { auto rr=__builtin_amdgcn_permlane32_swap(__float_as_uint(rm),__float_as_uint(rm),false,false); rm=__builtin_fmaxf(__uint_as_float(rr[0]),__uint_as_float(rr[1])); } \
      resc=false; \
      if(__builtin_expect(__any(rm>(float)THRL),0)){ const float dl=__builtin_fmaxf(rm,0.f); mhat+=dl; \
        _Pragma("unroll") for(int r=0;r<16;++r){C0[r]-=dl;C1[r]-=dl;} \
         \
        const float f=__builtin_amdgcn_exp2f(-dl); l_reg*=f; if(hi==0)wsf[r32]=f; resc=true; } } \
    SBAR(); \
    GAPB(o[0]=__builtin_amdgcn_mfma_f32_32x32x16_bf16(PAF(0),VFR(0),o[0],0,0,0), C0,0); \
    GAPB(o[1]=__builtin_amdgcn_mfma_f32_32x32x16_bf16(PAF(0),VFR(4),o[1],0,0,0), C0,4); \
    KRD(GL,0); GAPB(o[0]=__builtin_amdgcn_mfma_f32_32x32x16_bf16(PAF(1),VFR(1),o[0],0,0,0), C0,8); \
    KRD(GL,1); GAPB(o[1]=__builtin_amdgcn_mfma_f32_32x32x16_bf16(PAF(1),VFR(5),o[1],0,0,0), C0,12); \
    KRD(GL,2); GAPB(o[0]=__builtin_amdgcn_mfma_f32_32x32x16_bf16(PAF(2),VFR(2),o[0],0,0,0), C1,0); \
    KRD(GL,3); GAPB(o[1]=__builtin_amdgcn_mfma_f32_32x32x16_bf16(PAF(2),VFR(6),o[1],0,0,0), C1,4); \
    GAPB(o[0]=__builtin_amdgcn_mfma_f32_32x32x16_bf16(PAF(3),VFR(3),o[0],0,0,0), C1,8); \
    GAPB(o[1]=__builtin_amdgcn_mfma_f32_32x32x16_bf16(PAF(3),VFR(7),o[1],0,0,0), C1,12); \
    }while(0)
  int t=1;
  #undef CMASK
  #define CMASK(P0,P1,t) do{}while(0)
  for(;t+5<NT;t+=2){
    STEP(pB0,pB1,pA0,pA1,t,true,true,true);     WAIT_BAR(2); RESC(); ROT();
    STEP(pA0,pA1,pB0,pB1,t+1,true,true,true);   WAIT_BAR(2); RESC(); ROT();
  }
  #undef CMASK
  #define CMASK(P0,P1,t) do{int jb_=(t)-(NT-4); if(jb_>=0)cmask(P0,P1,jb_,qrel,hi);}while(0)
  #define ENDW(tt) do{ if((tt)+3<NT){WAIT_BAR(2);} else if((tt)+2<NT){WAIT_BAR(1);} else {WAIT_BAR(0);} }while(0)
  for(;t+1<NT;t+=2){
    STEP(pB0,pB1,pA0,pA1,t,(t+3<NT),(t+1<NT),(t+1<NT));       ENDW(t);   RESC(); ROT();
    STEP(pA0,pA1,pB0,pB1,t+1,(t+4<NT),(t+2<NT),(t+2<NT));     ENDW(t+1); RESC(); ROT();
  }
  STEP(pB0,pB1,pA0,pA1,NT-1,false,false,false); RESC();
  { float sacc=pB0[0]+pB0[1]; _Pragma("unroll") for(int r=2;r<16;++r)sacc+=pB0[r]; _Pragma("unroll") for(int r=0;r<16;++r)sacc+=pB1[r]; l_reg+=sacc;
    pw0=(u32x4){PKW(pB0,0),PKW(pB0,2),PKW(pB0,4),PKW(pB0,6)};pw1=(u32x4){PKW(pB0,8),PKW(pB0,10),PKW(pB0,12),PKW(pB0,14)};pw2=(u32x4){PKW(pB1,0),PKW(pB1,2),PKW(pB1,4),PKW(pB1,6)};pw3=(u32x4){PKW(pB1,8),PKW(pB1,10),PKW(pB1,12),PKW(pB1,14)};
    SBAR(); pv(o,vb0+sl_cur,PAF(0),PAF(1),PAF(2),PAF(3)); }
  #undef PKW
  #undef PAF
  #undef VFR
  #undef PIN
  #undef MX3
  #undef GAPA
  #undef GAPB
  #undef EX
  #undef VRD
  #undef KRD
  #undef STEP
  #undef ENDW
  {auto rr=__builtin_amdgcn_permlane32_swap(__float_as_uint(l_reg),__float_as_uint(l_reg),false,false);l_reg=__uint_as_float(rr[0])+__uint_as_float(rr[1]);}
  if(hi==0)wsf[32+r32]=l_reg;asm volatile("s_waitcnt lgkmcnt(0)":::"memory");
  float rli[16];
  #pragma unroll
  for(int r=0;r<16;++r)rli[r]=__builtin_amdgcn_rcpf(wsf[32+crow(r,hi)]);
  bf16*Ow=O+(rowbase+q0+wid*QBLK)*DM+h*D;
  { bf16*stg=(bf16*)(shm+LDS_OST)+wid*2048;
    #pragma unroll
    for(int r=0;r<16;++r){const int orow=crow(r,hi);
      #pragma unroll
      for(int d0=0;d0<2;++d0)stg[orow*64+d0*32+r32]=__float2bfloat16(o[d0][r]*rli[r]);}
    asm volatile("s_waitcnt lgkmcnt(0)":::"memory");
    #pragma unroll
    for(int i=0;i<4;++i){const int row=i*8+(lane>>3),ch=lane&7; const u32x4 v=*(const u32x4*)(stg+row*64+ch*8); ATTN_STORE16(Ow+(long)row*DM+ch*8,v);} }
  asm volatile("s_waitcnt lgkmcnt(0)\n\ts_barrier":::"memory");
  #undef DMA_K
  #undef DMA_V
  #undef CMASK
  #undef START
  #undef RESC
  #undef ROT
  #undef CINIT
}
constexpr int ATTN_LDS_BYTES=LDS_BYTES;
#undef SBAR
#undef WAIT_BAR
}
namespace cg = cooperative_groups;
#define GAS __attribute__((address_space(1)))
#define LAS __attribute__((address_space(3)))
typedef unsigned short bf16_t;
typedef unsigned v4u __attribute__((ext_vector_type(4)));
typedef unsigned v2u __attribute__((ext_vector_type(2)));
typedef float f32x4 __attribute__((ext_vector_type(4)));
typedef float f32x16 __attribute__((ext_vector_type(16)));
typedef short bf16x8 __attribute__((ext_vector_type(8)));
constexpr int NWAVES = 8, NTHR = 512;
constexpr int TP = 32768, TS = 512, T = TP + TS, D = 1024, DFF = 2816, DFF2 = 5632, NH = 16, HD = 64;
constexpr int SEQP = 8192, SEQS = 32, PAST = 4096, SKS = PAST + SEQS, NBP = 4, NBS = 16;
constexpr float EPS = 1e-6f, LOG2E = 1.4426950408889634f, C2 = 0.125f * 1.4426950408889634f;
constexpr size_t O_Y = 0, O_SGUV = 34078720, O_CONVP = 34603008, O_CONVS = 34693120, O_KP = 35053568, O_VP = 68608000, O_LFP = 102162432,
                 O_KS = 102686720, O_VS = 103211008, O_LFS = 103735296, O_END = 103743488;
constexpr size_t MiB = 1u << 20;
constexpr size_t WS_WF = 1 * MiB, WS_WSM = WS_WF + 65536, WS_WIN = 2 * MiB, WS_WOUT = 6 * MiB, WS_WUP0 = 8 * MiB, WS_WUP1 = 19 * MiB, WS_WDN0 = 30 * MiB, WS_WDN1 = 36 * MiB,
                 WS_WQKV = 42 * MiB, WS_WO = 48 * MiB, WS_SSQ0 = 50 * MiB, WS_SSQ1 = 53 * MiB, WS_SSQ2 = 56 * MiB, WS_SSQ3 = 59 * MiB, WS_VSTAT = 62 * MiB,
                 WS_CKP = 67 * MiB, WS_CKS = 69 * MiB, WS_R0 = 74 * MiB, WS_R1 = 139 * MiB, WS_R2 = 204 * MiB, WS_HB = 269 * MiB, WS_A = 334 * MiB, WS_G = 692 * MiB, WS_END = 871 * MiB;
constexpr int RING_BYTES = 131072, LDS_BYTES = 147456;

__device__ __forceinline__ unsigned f2bf(float f) { unsigned u = __builtin_bit_cast(unsigned, f); return (u + 0x7fffu + ((u >> 16) & 1u)) >> 16; }
__device__ __forceinline__ unsigned pk2(float lo, float hi) { return pg8::cvt_pk_bf16(lo, hi); }
__device__ __forceinline__ float bflo(unsigned w) { return __uint_as_float(w << 16); }
__device__ __forceinline__ float bfhi(unsigned w) { return __uint_as_float(w & 0xffff0000u); }
#define LDS_WAIT() asm volatile("s_waitcnt lgkmcnt(0)" ::: "memory")
__device__ __forceinline__ float wave_sum(float v) {
#pragma unroll
    for (int o = 1; o < 64; o <<= 1) v += __shfl_xor(v, o);
    return v;
}

struct Args { const float* in[27]; float* out; unsigned char* ws; int ph_lo, ph_hi; };
typedef const __attribute__((address_space(4))) Args* ArgP;

__device__ __forceinline__ void transpose_item(const float* W, int K, int N, bf16_t* WT, const float* g, int mode, int row_off, LAS float* scr, int item, int lane) {
    const int nblk = N / 32, kb = item / nblk, nb = item % nblk, k0 = 64 * kb, n0 = 32 * nb;
    float wv[32];
#pragma unroll
    for (int i = 0; i < 32; ++i) wv[i] = W[(size_t)(k0 + 2 * i + (lane >> 5)) * N + n0 + (lane & 31)];
#pragma unroll
    for (int i = 0; i < 32; ++i) { const int kk = 2 * i + (lane >> 5); float w = wv[i]; if (g) w *= g[k0 + kk]; scr[kk * 33 + (lane & 31)] = w; }
    LDS_WAIT(); asm volatile("" ::: "memory");
    const int c = lane & 7;
#pragma unroll
    for (int j = 0; j < 4; ++j) { const int n = (lane >> 3) + 8 * j; const LAS float* s = scr + (8 * c) * 33 + n;
        v4u o; o.x = pk2(s[0 * 33], s[1 * 33]); o.y = pk2(s[2 * 33], s[3 * 33]); o.z = pk2(s[4 * 33], s[5 * 33]); o.w = pk2(s[6 * 33], s[7 * 33]);
        int nn = n0 + n; if (mode == 1) { const int l = nn & 255; nn = (nn & ~255) + 128 * ((l >> 5) & 1) + 32 * (l >> 6) + (l & 31); }
        if (mode == 3) { const int bj = nn >= DFF ? 1 : 0, q = nn - bj * DFF; nn = 256 * (q >> 7) + 128 * bj + (q & 127); }
        *(v4u*)(WT + (size_t)(row_off + nn) * K + k0 + 8 * c) = o; }
    LDS_WAIT(); asm volatile("" ::: "memory");
}
__device__ __forceinline__ void x_rows4(ArgP a, int m0, int lane) {
    bf16_t* XB = (bf16_t*)(a->ws + WS_R0); float* ssq0 = (float*)(a->ws + WS_SSQ0);
    const float* xr = m0 < TP ? a->in[0] + (size_t)m0 * D : a->in[1] + (size_t)(m0 - TP) * D;
    f32x4 v[4][4];
#pragma unroll
    for (int r = 0; r < 4; ++r)
#pragma unroll
        for (int j = 0; j < 4; ++j) v[r][j] = __builtin_nontemporal_load((const f32x4*)(xr + (size_t)r * D) + lane + 64 * j);
#pragma unroll
    for (int r = 0; r < 4; ++r) { float s = 0.f;
#pragma unroll
        for (int j = 0; j < 4; ++j) { s += (v[r][j][0] * v[r][j][0] + v[r][j][1] * v[r][j][1]) + (v[r][j][2] * v[r][j][2] + v[r][j][3] * v[r][j][3]);
            v2u o; o.x = pk2(v[r][j][0], v[r][j][1]); o.y = pk2(v[r][j][2], v[r][j][3]); ((v2u*)(XB + (size_t)(m0 + r) * D))[lane + 64 * j] = o; }
        s = wave_sum(s);
        if (lane < 16) ssq0[(size_t)(m0 + r) * 16 + lane] = lane == 0 ? s : 0.f; }
}
__device__ __forceinline__ bool p0_prologue(ArgP a, LAS unsigned char* lds, int G, int bx, int tid, int wave, int lane, unsigned* ctr) {
    unsigned char* ws = a->ws;
    LAS float* scr = (LAS float*)(lds + wave * 16384);
    constexpr int I_IN = 16 * 64, I_OUT = 16 * 32, I_UP = 16 * 176, I_DN = 44 * 32, I_SQ = 16 * 32;
    constexpr int NITEMS = I_OUT + 2 * I_UP + 2 * I_DN + 4 * I_SQ;
    const bool split = G >= 32;
    for (int it = bx * NWAVES + wave; it < I_IN + TS / 4; it += G * NWAVES) {
        if (it < I_IN) transpose_item(a->in[8], D, 2 * D, (bf16_t*)(ws + WS_WIN), a->in[6], 0, 0, scr, it, lane);
        else x_rows4(a, TP + 4 * (it - I_IN), lane);
    }
    if (split) { pg8::part_arrive(ctr, tid); if (bx < 16) { pg8::part_wait(ctr, (unsigned)G, tid); return true; } }
    const int skip = split ? 16 : 0, gw = (bx - skip) * NWAVES + wave, NGW = (G - skip) * NWAVES;
    for (int it = gw; it < NITEMS; it += NGW) {
        int r = it;
        if (r < I_OUT) { transpose_item(a->in[13], D, D, (bf16_t*)(ws + WS_WOUT), nullptr, 0, 0, scr, r, lane); continue; } r -= I_OUT;
        if (r < I_UP) { transpose_item(a->in[14], D, DFF2, (bf16_t*)(ws + WS_WUP0), a->in[7], 3, 0, scr, r, lane); continue; } r -= I_UP;
        if (r < I_UP) { transpose_item(a->in[14] + (size_t)D * DFF2, D, DFF2, (bf16_t*)(ws + WS_WUP1), a->in[7] + D, 3, 0, scr, r, lane); continue; } r -= I_UP;
        if (r < I_DN) { transpose_item(a->in[17], DFF, D, (bf16_t*)(ws + WS_WDN0), nullptr, 0, 0, scr, r, lane); continue; } r -= I_DN;
        if (r < I_DN) { transpose_item(a->in[17] + (size_t)DFF * D, DFF, D, (bf16_t*)(ws + WS_WDN1), nullptr, 0, 0, scr, r, lane); continue; } r -= I_DN;
        if (r < I_SQ) { transpose_item(a->in[24], D, D, (bf16_t*)(ws + WS_WQKV), a->in[6] + D, 1, 0, scr, r, lane); continue; } r -= I_SQ;
        if (r < I_SQ) { transpose_item(a->in[19], D, D, (bf16_t*)(ws + WS_WQKV), a->in[18], 1, D, scr, r, lane); continue; } r -= I_SQ;
        if (r < I_SQ) { transpose_item(a->in[20], D, D, (bf16_t*)(ws + WS_WQKV), a->in[18], 1, 2 * D, scr, r, lane); continue; } r -= I_SQ;
        transpose_item(a->in[26], D, D, (bf16_t*)(ws + WS_WO), nullptr, 0, 0, scr, r, lane);
    }
    { const int gt = gw * 64 + lane, NGT = NGW * 64; bf16_t* wf = (bf16_t*)(ws + WS_WF); bf16_t* wsm = (bf16_t*)(ws + WS_WSM);
        for (int e = gt; e < 16 * D; e += NGT) { const int n = e >> 10, k = e & 1023; wf[e] = (bf16_t)f2bf(a->in[22][k * 16 + n] * a->in[18][k]); }
        for (int e = gt; e < 4 * 128 * 128; e += NGT) { const int i = (e >> 7) & 127, j = e & 127; wsm[e] = (bf16_t)f2bf(((j >> 6) <= (i >> 6)) ? a->in[11][e] : 0.f); } }
    for (int m0 = gw * 4; m0 < TP; m0 += NGW * 4) x_rows4(a, m0, lane);
    return false;
}

__device__ __forceinline__ void sgu_unit(ArgP a, LAS unsigned char* lds, int un, int tid, int wave, int lane) {
    unsigned char* ws = a->ws;
    const bf16_t* U = (const bf16_t*)(ws + WS_R1); const bf16_t* VP = (const bf16_t*)(ws + WS_R2); bf16_t* SG = (bf16_t*)(ws + WS_G);
    const float* vstat = (const float*)(ws + WS_VSTAT); const bf16_t* wsm = (const bf16_t*)(ws + WS_WSM);
    const float* lng = a->in[9]; const float* lnb = a->in[10]; const float* bs = a->in[12];
    constexpr int VPITCH = 136;
    LAS bf16_t* VT = (LAS bf16_t*)lds; LAS float* st = (LAS float*)(lds + 256 * VPITCH * 2);
    {
        const int nb = un >> 2, g = un & 3; const bool smp = nb >= 256;
        const int row0 = smp ? TP + (nb - 256) * 32 : nb * 128, nrows = smp ? 32 : 128;
        if (tid < nrows) { const float* p = vstat + (size_t)(row0 + tid) * 32; float s = 0.f, s2 = 0.f;
#pragma unroll
            for (int k = 0; k < 16; ++k) { s += p[2 * k]; s2 += p[2 * k + 1]; }
            const float mean = s * (1.f / 1024.f), var = fmaxf(s2 * (1.f / 1024.f) - mean * mean, 0.f);
            st[2 * tid] = mean; st[2 * tid + 1] = __builtin_amdgcn_rsqf(var + EPS); }
        __syncthreads();
        const int fr0_ = lane & 15, fq0_ = lane >> 4, nit0_ = nrows >> 4; const bf16_t* wg0_ = wsm + (size_t)g * 128 * 128; bf16x8 wf0[8];
#pragma unroll
        for (int it = 0; it < 8; ++it) if (it < nit0_) wf0[it] = *(const bf16x8*)(wg0_ + (it * 16 + fr0_) * 128 + fq0_ * 8);
        const int jsh = smp ? 5 : 7;
        for (int it = tid; it < nrows * 32; it += NTHR) {
            const int j = it & (nrows - 1), cc = (it >> jsh) * 8, c = g * 256 + cc; const float mean = st[2 * j], rstd = st[2 * j + 1];
            const v4u raw = *(const v4u*)(VP + (size_t)(row0 + j) * D + c);
            const f32x4 g0 = *(const f32x4*)(lng + c), g1 = *(const f32x4*)(lng + c + 4), b0 = *(const f32x4*)(lnb + c), b1 = *(const f32x4*)(lnb + c + 4);
            float v[8];
            v[0] = (bflo(raw.x) - mean) * rstd * g0[0] + b0[0]; v[1] = (bfhi(raw.x) - mean) * rstd * g0[1] + b0[1];
            v[2] = (bflo(raw.y) - mean) * rstd * g0[2] + b0[2]; v[3] = (bfhi(raw.y) - mean) * rstd * g0[3] + b0[3];
            v[4] = (bflo(raw.z) - mean) * rstd * g1[0] + b1[0]; v[5] = (bfhi(raw.z) - mean) * rstd * g1[1] + b1[1];
            v[6] = (bflo(raw.w) - mean) * rstd * g1[2] + b1[2]; v[7] = (bfhi(raw.w) - mean) * rstd * g1[3] + b1[3];
            if (smp) { float* o = a->out + O_SGUV + (size_t)(row0 - TP + j) * D + c; *(f32x4*)o = (f32x4){v[0], v[1], v[2], v[3]}; *(f32x4*)(o + 4) = (f32x4){v[4], v[5], v[6], v[7]}; }
#pragma unroll
            for (int e = 0; e < 8; ++e) VT[(cc + e) * VPITCH + j] = (bf16_t)f2bf(v[e]);
        }
        __syncthreads();
        const int fr = lane & 15, fq = lane >> 4, nit = nrows >> 4, nks = nrows >> 5;
        f32x4 acc[8][2];
#pragma unroll
        for (int i = 0; i < 8; ++i) { acc[i][0] = (f32x4){0.f, 0.f, 0.f, 0.f}; acc[i][1] = (f32x4){0.f, 0.f, 0.f, 0.f}; }
        const bf16_t* wg = wsm + (size_t)g * 128 * 128;
#pragma unroll 2
        for (int ks = 0; ks < nks; ++ks) {
            bf16x8 wfr[8];
#pragma unroll
            for (int it = 0; it < 8; ++it) if (it < nit) wfr[it] = ks == 0 ? wf0[it] : *(const bf16x8*)(wg + (it * 16 + fr) * 128 + ks * 32 + fq * 8);
            const bf16x8 va = *(const LAS bf16x8*)(VT + (wave * 32 + fr) * VPITCH + ks * 32 + fq * 8);
            const bf16x8 vb = *(const LAS bf16x8*)(VT + (wave * 32 + 16 + fr) * VPITCH + ks * 32 + fq * 8);
#pragma unroll
            for (int it = 0; it < 8; ++it) if (it < nit) {
                const bf16x8 wf = wfr[it];
                acc[it][0] = __builtin_amdgcn_mfma_f32_16x16x32_bf16(va, wf, acc[it][0], 0, 0, 0);
                acc[it][1] = __builtin_amdgcn_mfma_f32_16x16x32_bf16(vb, wf, acc[it][1], 0, 0, 0);
            }
        }
#pragma unroll
        for (int it = 0; it < 8; ++it) if (it < nit) {
            const int i = it * 16 + fr; const float bsv = bs[g * 128 + i];
#pragma unroll
            for (int ct = 0; ct < 2; ++ct) { const size_t off = (size_t)(row0 + i) * D + g * 256 + wave * 32 + ct * 16 + 4 * fq;
                const v2u uu = *(const v2u*)(U + off); const f32x4 m = acc[it][ct] + bsv;
                v2u o; o.x = pk2(bflo(uu.x) * m[0], bfhi(uu.x) * m[1]); o.y = pk2(bflo(uu.y) * m[2], bfhi(uu.y) * m[3]); *(v2u*)(SG + off) = o; }
        }
        __syncthreads();
    }
}

__device__ __forceinline__ void load8(const bf16_t* p, float (&o)[8]) { const v4u r = *(const v4u*)p; o[0] = bflo(r.x); o[1] = bfhi(r.x); o[2] = bflo(r.y); o[3] = bfhi(r.y); o[4] = bflo(r.z); o[5] = bfhi(r.z); o[6] = bflo(r.w); o[7] = bfhi(r.w); }
__device__ __forceinline__ void load8f(const float* p, float (&o)[8]) { const f32x4 a = *(const f32x4*)p, b = *(const f32x4*)(p + 4); o[0] = a[0]; o[1] = a[1]; o[2] = a[2]; o[3] = a[3]; o[4] = b[0]; o[5] = b[1]; o[6] = b[2]; o[7] = b[3]; }
__device__ __forceinline__ void ctr_arrive(unsigned* ctr, int tid) {
    asm volatile("s_waitcnt vmcnt(0)" ::: "memory"); __syncthreads();
    if (__builtin_amdgcn_readfirstlane(tid >> 6) == 0) { __builtin_amdgcn_fence(__ATOMIC_RELEASE, "agent"); asm volatile("s_waitcnt vmcnt(0)" ::: "memory");
        __hip_atomic_fetch_add(ctr, (tid & 63) == 0 ? 1u : 0u, __ATOMIC_RELAXED, __HIP_MEMORY_SCOPE_AGENT); }
}
__device__ __forceinline__ void ctr_wait(unsigned* ctr, unsigned need, int tid) {
    if (__builtin_amdgcn_readfirstlane(tid >> 6) == 0) {
        while ((unsigned)__builtin_amdgcn_readfirstlane((int)__hip_atomic_load(ctr, __ATOMIC_RELAXED, __HIP_MEMORY_SCOPE_AGENT)) < need) __builtin_amdgcn_s_sleep(2);
        __builtin_amdgcn_fence(__ATOMIC_ACQUIRE, "agent"); asm volatile("s_waitcnt vmcnt(0)" ::: "memory"); }
    __syncthreads();
}
__device__ __forceinline__ void conv_item(const bf16_t* A, bf16_t* Gb, const float* cw, const float* cb, const float* cst, int rb, int jc) {
    const int r0 = rb * 16, col = jc * 8;
    float w0g[8], w1g[8], w2g[8], bg[8], w0v[8], w1v[8], w2v[8], bv[8];
    load8f(cw + col, w0g); load8f(cw + DFF2 + col, w1g); load8f(cw + 2 * DFF2 + col, w2g); load8f(cb + col, bg);
    load8f(cw + DFF + col, w0v); load8f(cw + DFF2 + DFF + col, w1v); load8f(cw + 2 * DFF2 + DFF + col, w2v); load8f(cb + DFF + col, bv);
    float g2[8], g1[8], v2[8], v1[8];
    const int t0 = r0 < TP ? (r0 & (SEQP - 1)) : ((r0 - TP) & (SEQS - 1));
    if (t0 == 0) {
        if (r0 < TP) {
#pragma unroll
            for (int e = 0; e < 8; ++e) { g2[e] = 0.f; g1[e] = 0.f; v2[e] = 0.f; v1[e] = 0.f; }
        } else { const float* sp = cst + (size_t)((r0 - TP) >> 5) * 2 * DFF2 + col; load8f(sp, g2); load8f(sp + DFF2, g1); load8f(sp + DFF, v2); load8f(sp + DFF2 + DFF, v1); }
    } else { const bf16_t* ap = A + (size_t)(r0 - 2) * DFF2 + col; load8(ap, g2); load8(ap + DFF2, g1); load8(ap + DFF, v2); load8(ap + DFF2 + DFF, v1); }
#pragma unroll 2
    for (int i = 0; i < 16; ++i) {
        const bf16_t* ap = A + (size_t)(r0 + i) * DFF2 + col; float g0[8], v0[8]; load8(ap, g0); load8(ap + DFF, v0);
        float o[8];
#pragma unroll
        for (int e = 0; e < 8; ++e) { const float cgv = g0[e] * w2g[e] + g1[e] * w1g[e] + g2[e] * w0g[e] + bg[e], cvv = v0[e] * w2v[e] + v1[e] * w1v[e] + v2[e] * w0v[e] + bv[e];
            o[e] = cgv * __builtin_amdgcn_rcpf(1.0f + __builtin_amdgcn_exp2f(-LOG2E * cgv)) * cvv; g2[e] = g1[e]; g1[e] = g0[e]; v2[e] = v1[e]; v1[e] = v0[e]; }
        v4u w; w.x = pk2(o[0], o[1]); w.y = pk2(o[2], o[3]); w.z = pk2(o[4], o[5]); w.w = pk2(o[6], o[7]);
        *(v4u*)(Gb + (size_t)(r0 + i) * DFF + col) = w;
    }
}
__device__ __forceinline__ void conv_fix_item(const float* stash, bf16_t* Gb, const float* cw, const float* cb, int b, int jc) {
    const int col = jc * 8;
    float w0g[8], w1g[8], w2g[8], bg[8], w0v[8], w1v[8], w2v[8], bv[8];
    load8f(cw + col, w0g); load8f(cw + DFF2 + col, w1g); load8f(cw + 2 * DFF2 + col, w2g); load8f(cb + col, bg);
    load8f(cw + DFF + col, w0v); load8f(cw + DFF2 + DFF + col, w1v); load8f(cw + 2 * DFF2 + DFF + col, w2v); load8f(cb + DFF + col, bv);
    float g2[8], g1[8], v2[8], v1[8], c0g[8], c0v[8], c1g[8], c1v[8];
    const float* sb = stash + (size_t)b * 8 * DFF + col;
    load8f(sb, c0g); load8f(sb + DFF, c0v); load8f(sb + 2 * DFF, c1g); load8f(sb + 3 * DFF, c1v);
    if ((b & 127) == 0) {
#pragma unroll
        for (int e = 0; e < 8; ++e) { g2[e] = 0.f; g1[e] = 0.f; v2[e] = 0.f; v1[e] = 0.f; }
    } else { const float* sp = sb - (size_t)8 * DFF; load8f(sp + 4 * DFF, g2); load8f(sp + 5 * DFF, v2); load8f(sp + 6 * DFF, g1); load8f(sp + 7 * DFF, v1); }
    float o0[8], o1[8];
#pragma unroll
    for (int e = 0; e < 8; ++e) {
        const float a0 = c0g[e] * w2g[e] + g1[e] * w1g[e] + g2[e] * w0g[e] + bg[e], b0 = c0v[e] * w2v[e] + v1[e] * w1v[e] + v2[e] * w0v[e] + bv[e];
        const float a1 = c1g[e] * w2g[e] + c0g[e] * w1g[e] + g1[e] * w0g[e] + bg[e], b1 = c1v[e] * w2v[e] + c0v[e] * w1v[e] + v1[e] * w0v[e] + bv[e];
        o0[e] = a0 * __builtin_amdgcn_rcpf(1.0f + __builtin_amdgcn_exp2f(-LOG2E * a0)) * b0; o1[e] = a1 * __builtin_amdgcn_rcpf(1.0f + __builtin_amdgcn_exp2f(-LOG2E * a1)) * b1; }
    v4u w; w.x = pk2(o0[0], o0[1]); w.y = pk2(o0[2], o0[3]); w.z = pk2(o0[4], o0[5]); w.w = pk2(o0[6], o0[7]); *(v4u*)(Gb + (size_t)(b * 64) * DFF + col) = w;
    w.x = pk2(o1[0], o1[1]); w.y = pk2(o1[2], o1[3]); w.z = pk2(o1[4], o1[5]); w.w = pk2(o1[6], o1[7]); *(v4u*)(Gb + (size_t)(b * 64 + 1) * DFF + col) = w;
}
__device__ __forceinline__ bool conv_phase(ArgP a, int layer, int G, int tid, int bx, unsigned* ctr) {
    const bf16_t* A = (const bf16_t*)(a->ws + WS_A); bf16_t* Gb = (bf16_t*)(a->ws + WS_G);
    const float* cw = a->in[15] + (size_t)layer * 3 * DFF2; const float* cb = a->in[16] + (size_t)layer * DFF2; const float* cst = a->in[5] + (size_t)layer * NBS * 2 * DFF2;
    constexpr int NJC = DFF / 8; const bool split = G >= 64;
    if (split) {
        for (int it = bx * NTHR + tid; it < (TS / 16) * NJC; it += G * NTHR) { const int rbl = it / NJC; conv_item(A, Gb, cw, cb, cst, TP / 16 + rbl, it - rbl * NJC); }
        ctr_arrive(ctr, tid);
        if (bx < 32) { ctr_wait(ctr, (unsigned)G, tid); return true; }
    }
    const int skip = split ? 32 : 0, gt = (bx - skip) * NTHR + tid, NGT = (G - skip) * NTHR;
    if (!split) for (int it = gt; it < (TS / 16) * NJC; it += NGT) { const int rbl = it / NJC; conv_item(A, Gb, cw, cb, cst, TP / 16 + rbl, it - rbl * NJC); }
    const float* stash = (const float*)(a->ws + WS_A);
    for (int it = gt; it < (TP / 64) * NJC; it += NGT) { const int b = it / NJC; conv_fix_item(stash, Gb, cw, cb, b, it - b * NJC); }
    return false;
}

__device__ __forceinline__ void logf_units(ArgP a, int gw, int NGW, int lane) {
    const bf16_t* HB = (const bf16_t*)(a->ws + WS_HB); const bf16_t* wf = (const bf16_t*)(a->ws + WS_WF); const float* ssq = (const float*)(a->ws + WS_SSQ2);
    const int fr = lane & 15, fq = lane >> 4; const float bf = a->in[23][fr];
    for (int grp = gw; grp < T / 16; grp += NGW) {
        const int row0 = grp * 16; f32x4 acc = (f32x4){0.f, 0.f, 0.f, 0.f};
        const bf16_t* ap = HB + (size_t)(row0 + fr) * D + fq * 8; const bf16_t* bp = wf + (size_t)fr * D + fq * 8;
#pragma unroll 8
        for (int ks = 0; ks < 32; ++ks) acc = __builtin_amdgcn_mfma_f32_16x16x32_bf16(*(const bf16x8*)(ap + ks * 32), *(const bf16x8*)(bp + ks * 32), acc, 0, 0, 0);
#pragma unroll
        for (int r = 0; r < 4; ++r) { const int row = row0 + 4 * fq + r; const f32x4* sp = (const f32x4*)(ssq + (size_t)row * 16);
            const f32x4 s0 = sp[0], s1 = sp[1], s2 = sp[2], s3 = sp[3];
            const float ss = ((s0[0] + s0[1]) + (s0[2] + s0[3])) + ((s1[0] + s1[1]) + (s1[2] + s1[3])) + ((s2[0] + s2[1]) + (s2[2] + s2[3])) + ((s3[0] + s3[1]) + (s3[2] + s3[3]));
            const float x = acc[r] * __builtin_amdgcn_rsqf(ss * (1.f / 1024.f) + EPS) + bf;
            const float lf = fminf(x, 0.f) - log1pf(__expf(-fabsf(x)));
            a->out[(row < TP ? O_LFP + (size_t)row * 16 : O_LFS + (size_t)(row - TP) * 16) + fr] = lf; }
    }
}

__device__ __forceinline__ void scan_unit(const float* src0, int n0, int stride0, const float* src1, int n1, int stride1, float* dst, LAS float* sh, int tid, int wave, int lane, int* ktab = nullptr, float ref_off = 0.f) {
    const int n = n0 + n1, base = tid * 16; float v[16]; float s = 0.f;
    const float* sp = nullptr; int st = 0;
    if (base < n0) { sp = src0 + (size_t)base * stride0; st = stride0; } else if (base < n) { sp = src1 + (size_t)(base - n0) * stride1; st = stride1; }
    if (sp) {
#pragma unroll
        for (int e = 0; e < 16; ++e) v[e] = sp[(size_t)e * st];
    } else {
#pragma unroll
        for (int e = 0; e < 16; ++e) v[e] = 0.f;
    }
#pragma unroll
    for (int e = 0; e < 16; ++e) { s += v[e]; v[e] = s; }
    float sc = s;
#pragma unroll
    for (int o = 1; o < 64; o <<= 1) { const float t = __shfl_up(sc, o); if (lane >= o) sc += t; }
    if (lane == 63) sh[wave] = sc;
    __syncthreads();
    float pre = 0.f;
#pragma unroll
    for (int w = 0; w < NWAVES; ++w) if (w < wave) pre += sh[w];
    const float excl = pre + sc - s;
    if (ktab) {
        LAS float* tl = sh + 16;
        if ((tid & 3) == 3) tl[tid >> 2] = -(excl + v[15]) * LOG2E;
        if ((tid & 15) == 0) tl[128 + (tid >> 4)] = -(excl + v[0]) * LOG2E;
        __syncthreads();
        if (tid < 32) { const float ref = tl[128 + tid] - ref_off; int lo_ = 0, hi_ = 4 * tid;
            while (lo_ < hi_) { const int mid = (lo_ + hi_ + 1) >> 1; if (tl[mid - 1] < ref) lo_ = mid; else hi_ = mid - 1; }
            ktab[tid] = lo_ & ~1; }
    }
    if (base < n) {
#pragma unroll
        for (int e = 0; e < 16; e += 4) *(f32x4*)(dst + base + e) = (f32x4){-(excl + v[e]) * LOG2E, -(excl + v[e + 1]) * LOG2E, -(excl + v[e + 2]) * LOG2E, -(excl + v[e + 3]) * LOG2E};
    }
    __syncthreads();
}

__device__ __forceinline__ bf16x8 pack8(const f32x4 a, const f32x4 b) { v4u w; w.x = pk2(a[0], a[1]); w.y = pk2(a[2], a[3]); w.z = pk2(b[0], b[1]); w.w = pk2(b[2], b[3]); return __builtin_bit_cast(bf16x8, w); }
__device__ __forceinline__ void attn_sample_unit(ArgP a, int s, int h, LAS unsigned char* lds, int tid, int wave, int lane) {
    const bf16_t* Q = (const bf16_t*)(a->ws + WS_R0); const bf16_t* Kn = (const bf16_t*)(a->ws + WS_R1); const bf16_t* Vn = (const bf16_t*)(a->ws + WS_R2); bf16_t* O = (bf16_t*)(a->ws + WS_R0);
    const float* kb = (const float*)(a->ws + WS_CKS) + (size_t)(s * NH + h) * SKS;
    const float* ck = a->in[2] + ((size_t)s * PAST * NH + h) * HD; const float* cv = a->in[3] + ((size_t)s * PAST * NH + h) * HD;
    const int r32 = lane & 31, hi = lane >> 5, row0 = TP + s * SEQS;
    bf16x8 qr[4];
#pragma unroll
    for (int d0 = 0; d0 < 4; ++d0) qr[d0] = *(const bf16x8*)(Q + (size_t)(row0 + r32) * D + h * HD + d0 * 16 + hi * 8);
    float m = -1e30f, l = 0.f; f32x16 o0 = {}, o1 = {};
#define SMP_TILE(kf, vf, kbp, MASK) do { f32x16 p; \
        _Pragma("unroll") for (int g_ = 0; g_ < 4; ++g_) { const f32x4 bb = *(const f32x4*)((kbp) + 8 * g_ + 4 * hi); p[4 * g_] = bb[0]; p[4 * g_ + 1] = bb[1]; p[4 * g_ + 2] = bb[2]; p[4 * g_ + 3] = bb[3]; } \
        _Pragma("unroll") for (int d0 = 0; d0 < 4; ++d0) p = __builtin_amdgcn_mfma_f32_32x32x16_bf16(kf[d0], qr[d0], p, 0, 0, 0); \
        if (MASK) { _Pragma("unroll") for (int r = 0; r < 16; ++r) { const int key = (r & 3) + 8 * (r >> 2) + 4 * hi; if (key > r32) p[r] = -1e30f; } } \
        float mx = p[0]; _Pragma("unroll") for (int r = 1; r < 16; ++r) mx = fmaxf(mx, p[r]); \
        mx = fmaxf(mx, __shfl_xor(mx, 32)); const float mn = fmaxf(m, mx), f = __builtin_amdgcn_exp2f(m - mn); m = mn; float ls = 0.f; \
        _Pragma("unroll") for (int r = 0; r < 16; ++r) { p[r] = __builtin_amdgcn_exp2f(p[r] - mn); ls += p[r]; } \
        l = l * f + ls; o0 = o0 * f; o1 = o1 * f; \
        v4u w0, w1; w0.x = pk2(p[0], p[1]); w0.y = pk2(p[2], p[3]); w0.z = pk2(p[4], p[5]); w0.w = pk2(p[6], p[7]); w1.x = pk2(p[8], p[9]); w1.y = pk2(p[10], p[11]); w1.z = pk2(p[12], p[13]); w1.w = pk2(p[14], p[15]); \
        const bf16x8 pw0 = __builtin_bit_cast(bf16x8, w0), pw1 = __builtin_bit_cast(bf16x8, w1); \
        o0 = __builtin_amdgcn_mfma_f32_32x32x16_bf16(vf[0][0], pw0, o0, 0, 0, 0); o0 = __builtin_amdgcn_mfma_f32_32x32x16_bf16(vf[0][1], pw1, o0, 0, 0, 0); \
        o1 = __builtin_amdgcn_mfma_f32_32x32x16_bf16(vf[1][0], pw0, o1, 0, 0, 0); o1 = __builtin_amdgcn_mfma_f32_32x32x16_bf16(vf[1][1], pw1, o1, 0, 0, 0); } while (0)
    f32x4 kraw[8]; float vraw[32];
#define SMP_LOAD(tt_) do { const int key0_ = (wave * 16 + (tt_)) * 32; const float* kp_ = ck + (size_t)(key0_ + r32) * (NH * HD) + hi * 8; \
        _Pragma("unroll") for (int d0 = 0; d0 < 4; ++d0) { kraw[2 * d0] = *(const f32x4*)(kp_ + d0 * 16); kraw[2 * d0 + 1] = *(const f32x4*)(kp_ + d0 * 16 + 4); } \
        _Pragma("unroll") for (int d0b = 0; d0b < 2; ++d0b) _Pragma("unroll") for (int ks = 0; ks < 2; ++ks) _Pragma("unroll") for (int e = 0; e < 8; ++e) \
            vraw[(d0b * 2 + ks) * 8 + e] = cv[(size_t)(key0_ + 16 * ks + 4 * hi + (e & 3) + 8 * (e >> 2)) * (NH * HD) + d0b * 32 + r32]; } while (0)
    SMP_LOAD(0);
    for (int tt = 0; tt < 16; ++tt) {
        const int key0 = (wave * 16 + tt) * 32;
        bf16x8 kf[4], vf[2][2];
#pragma unroll
        for (int d0 = 0; d0 < 4; ++d0) kf[d0] = pack8(kraw[2 * d0], kraw[2 * d0 + 1]);
#pragma unroll
        for (int d0b = 0; d0b < 2; ++d0b)
#pragma unroll
            for (int ks = 0; ks < 2; ++ks) { const float* x = vraw + (d0b * 2 + ks) * 8; vf[d0b][ks] = pack8((f32x4){x[0], x[1], x[2], x[3]}, (f32x4){x[4], x[5], x[6], x[7]}); }
        if (tt + 1 < 16) SMP_LOAD(tt + 1);
        SMP_TILE(kf, vf, kb + key0, false);
    }
#undef SMP_LOAD
    if (wave == 0) {
        bf16x8 kf[4], vf[2][2];
#pragma unroll
        for (int d0 = 0; d0 < 4; ++d0) kf[d0] = *(const bf16x8*)(Kn + (size_t)(row0 + r32) * D + h * HD + d0 * 16 + hi * 8);
#pragma unroll
        for (int d0b = 0; d0b < 2; ++d0b)
#pragma unroll
            for (int ks = 0; ks < 2; ++ks) { unsigned x[8];
#pragma unroll
                for (int e = 0; e < 8; ++e) x[e] = Vn[(size_t)(row0 + 16 * ks + 4 * hi + (e & 3) + 8 * (e >> 2)) * D + h * HD + d0b * 32 + r32];
                v4u w; w.x = x[0] | (x[1] << 16); w.y = x[2] | (x[3] << 16); w.z = x[4] | (x[5] << 16); w.w = x[6] | (x[7] << 16); vf[d0b][ks] = __builtin_bit_cast(bf16x8, w); }
        SMP_TILE(kf, vf, kb + PAST, true);
    }
#undef SMP_TILE
    l += __shfl_xor(l, 32);
    LAS float* po = (LAS float*)lds + wave * 2048; LAS float* pm = (LAS float*)(lds + 65536) + wave * 64;
#pragma unroll
    for (int r = 0; r < 16; ++r) { const int d = (r & 3) + 8 * (r >> 2) + 4 * hi; po[d * 32 + r32] = o0[r]; po[(d + 32) * 32 + r32] = o1[r]; }
    if (hi == 0) { pm[r32] = m; pm[32 + r32] = l; }
    __syncthreads();
    { const int q = tid & 31, d0 = (tid >> 5) * 4; float M = -1e30f;
#pragma unroll
        for (int w = 0; w < NWAVES; ++w) M = fmaxf(M, ((LAS float*)(lds + 65536))[w * 64 + q]);
        float L = 0.f, oo[4] = {0.f, 0.f, 0.f, 0.f};
#pragma unroll
        for (int w = 0; w < NWAVES; ++w) { const float f = __builtin_amdgcn_exp2f(((LAS float*)(lds + 65536))[w * 64 + q] - M); L += f * ((LAS float*)(lds + 65536))[w * 64 + 32 + q];
#pragma unroll
            for (int e = 0; e < 4; ++e) oo[e] += f * ((LAS float*)lds)[w * 2048 + (d0 + e) * 32 + q]; }
        const float rl = 1.0f / L; v2u o; o.x = pk2(oo[0] * rl, oo[1] * rl); o.y = pk2(oo[2] * rl, oo[3] * rl);
        *(v2u*)(O + (size_t)(row0 + q) * D + h * HD + d0) = o; }
    __syncthreads();
}

constexpr int NPHASE = 14;
__global__ void __launch_bounds__(NTHR, 2) yoco_fwd(Args args) {
    extern __shared__ __attribute__((aligned(16))) unsigned char lds_raw[];
    cg::grid_group grid = cg::this_grid();
    LAS unsigned char* lds = (LAS unsigned char*)lds_raw;
    const int G = gridDim.x, bx = blockIdx.x, vcu = (G % 8 == 0) ? (bx % 8) * (G / 8) + bx / 8 : bx;
    const int NGW = G * NWAVES;
    const int wv0 = __builtin_amdgcn_readfirstlane((int)threadIdx.x >> 6);
    const int vblk = bx;
#define MYTID() ((wv0 << 6) | (int)__builtin_amdgcn_mbcnt_hi(~0u, __builtin_amdgcn_mbcnt_lo(~0u, 0u)))
#define TIDS() const int tid = ({ int t_ = MYTID(); asm volatile("" : "+v"(t_)); t_; }), lane = tid & 63, wave = __builtin_amdgcn_readfirstlane(tid >> 6), gw = vcu * NWAVES + wave; (void)lane; (void)gw
    ArgP argp = (ArgP)__builtin_amdgcn_kernarg_segment_ptr();
#define AP() ({ ArgP p_ = argp; asm volatile("" : "+s"(p_)); p_; })
    unsigned char* ws = args.ws; float* out = args.out;
    const int lo = args.ph_lo, hi = args.ph_hi;
#define IN(k) (lo <= (k) && (k) < hi)
#ifndef PROBE_DUP
#define PROBE_DUP 0
#endif
#define REP(k) for (int rep_ = 0; rep_ <= ((PROBE_DUP >> (k)) & 1); ++rep_)
#define SEAM(k) do { if (IN(k) && IN((k) + 1)) { if ((k) == 0) grid.sync(); else { const int t_ = MYTID(); unsigned* gb_ = (unsigned*)args.ws + 1024; ctr_arrive(gb_, t_); ctr_wait(gb_, (unsigned)(G * (k)), t_); } } } while (0)
    bf16_t* R0 = (bf16_t*)(ws + WS_R0); bf16_t* R1 = (bf16_t*)(ws + WS_R1); bf16_t* R2 = (bf16_t*)(ws + WS_R2); bf16_t* HB = (bf16_t*)(ws + WS_HB);
    bf16_t* Ab = (bf16_t*)(ws + WS_A); bf16_t* Gb = (bf16_t*)(ws + WS_G); float* HF = out + O_Y;
    float* ssq0 = (float*)(ws + WS_SSQ0); float* ssq1 = (float*)(ws + WS_SSQ1); float* ssq2 = (float*)(ws + WS_SSQ2); float* ssq3 = (float*)(ws + WS_SSQ3);

    if (IN(0)) REP(0) { if (rep_) grid.sync(); TIDS();
        if (p0_prologue(AP(), lds, G, bx, tid, wave, lane, (unsigned*)ws + 2112)) {
            pg8::Gemm g{R0, (const bf16_t*)(ws + WS_WIN), T, 2 * D, D}; pg8::OneUnit S{TP / 256 + (bx >> 3), bx & 7};
            pg8::EpiSguIn E{ssq0, R1, R2, (float*)(ws + WS_VSTAT)};
            pg8::gemm_phase<pg8::EpiSguIn, pg8::OneUnit, true, true>(lds, g, S, E, wv0); } }
    SEAM(0);
    if (IN(1)) REP(1) { if (rep_) grid.sync();
        pg8::Gemm g{R0, (const bf16_t*)(ws + WS_WIN), T, 2 * D, D}; pg8::StaticOrder S; S.init(G >= 32 ? TP : T, 2 * D, G, vblk);
        pg8::EpiSguIn E{ssq0, R1, R2, (float*)(ws + WS_VSTAT)};
        pg8::gemm_phase<pg8::EpiSguIn, pg8::StaticOrder, true, true>(lds, g, S, E, wv0);
    }
    SEAM(1);
    if (IN(2)) REP(2) { if (rep_) grid.sync(); TIDS();
        unsigned* q2 = (unsigned*)ws + 320; unsigned* c_sgus = (unsigned*)ws + 384; unsigned* c_p3s = (unsigned*)ws + 448;
        LAS unsigned* ubox = (LAS unsigned*)(lds + RING_BYTES);
        constexpr unsigned S_A = 64, S_B = S_A + 256, S_C = S_B + 8, S_D = S_C + 512, S_E = S_D + 44, S_END = S_E + 256;
        for (;;) {
            if (wave == 0) ubox[0] = (unsigned)__builtin_amdgcn_readfirstlane((int)__hip_atomic_fetch_add(q2, lane == 0 ? 1u : 0u, __ATOMIC_RELAXED, __HIP_MEMORY_SCOPE_AGENT));
            __syncthreads();
            const unsigned un = (unsigned)__builtin_amdgcn_readfirstlane((int)ubox[0]);
            __syncthreads();
            if (un >= S_END) break;
            int v;
            if (un < S_A) { sgu_unit(AP(), lds, 1024 + (int)un, tid, wave, lane); ctr_arrive(c_sgus, tid); continue; }
            else if (un < S_B) v = (int)(un - S_A);
            else if (un < S_C) { const int k = (int)(un - S_B); ctr_wait(c_sgus, 64u, tid);
                pg8::Gemm g{Gb, (const bf16_t*)(ws + WS_WOUT), T, D, D}; pg8::OneUnit S{TP / 256 + (k >> 2), k & 3}; pg8::EpiRes<false> E{R0, HB, ssq1, nullptr};
                pg8::gemm_phase<pg8::EpiRes<false>, pg8::OneUnit, true, true>(lds, g, S, E, wv0);
                ctr_arrive(c_p3s, tid); continue; }
            else if (un < S_D) v = (int)(un - S_C) + 256;
            else if (un < S_E) { const int k = (int)(un - S_D); ctr_wait(c_p3s, 8u, tid);
                pg8::Gemm g{HB, (const bf16_t*)(ws + WS_WUP0), T, DFF2, D}; pg8::OneUnit S{TP / 256 + k / 22, k % 22}; pg8::EpiUp<true> E{ssq1, Ab, Gb, (float*)(ws + WS_A), out + O_CONVP, out + O_CONVS, AP()->in[15], AP()->in[16]};
                pg8::gemm_phase<pg8::EpiUp<true>, pg8::OneUnit, true, true>(lds, g, S, E, wv0);
                continue; }
            else v = (int)(un - S_E) + 768;
            sgu_unit(AP(), lds, v, tid, wave, lane);
        }
    }
    SEAM(2);
    if (IN(3)) REP(3) { if (rep_) grid.sync();
        pg8::Gemm g{Gb, (const bf16_t*)(ws + WS_WOUT), T, D, D}; pg8::StaticOrder S; S.init(TP, D, G, vblk);
        pg8::EpiRes<false> E{R0, HB, ssq1, nullptr};
        pg8::gemm_phase<pg8::EpiRes<false>, pg8::StaticOrder, true, true>(lds, g, S, E, wv0);
    }
    SEAM(3);
    if (IN(4)) REP(4) { if (rep_) grid.sync();
        pg8::Gemm g{HB, (const bf16_t*)(ws + WS_WUP0), T, DFF2, D}; pg8::StaticOrder S; S.init(TP, DFF2, G, vblk);
        pg8::EpiUp<false> E{ssq1, Ab, Gb, (float*)(ws + WS_A), out + O_CONVP, out + O_CONVS, AP()->in[15], AP()->in[16]};
        pg8::gemm_phase<pg8::EpiUp<false>, pg8::StaticOrder, true, true>(lds, g, S, E, wv0);
    }
    SEAM(4);
    if (IN(5)) REP(5) { if (rep_) grid.sync(); TIDS();
        if (conv_phase(AP(), 0, G, tid, bx, (unsigned*)ws + 64)) {
            const int un_ = bx >> 2, qk = bx & 3, koff = qk < 2 ? qk * 768 : 1536 + (qk - 2) * 640, klen = qk < 2 ? 768 : 640;
            float* part = (float*)(ws + WS_R1) + (size_t)un_ * 3 * 65536; unsigned* pc = (unsigned*)ws + 1088 + 64 * un_;
            pg8::Gemm g{Gb + koff, (const bf16_t*)(ws + WS_WDN0) + koff, T, D, DFF, klen}; pg8::OneUnit S{TP / 256 + (un_ >> 2), un_ & 3};
            if (qk < 3) { pg8::EpiPart E{part + (size_t)qk * 65536, pc}; pg8::gemm_phase<pg8::EpiPart, pg8::OneUnit, true, true>(lds, g, S, E, wv0); }
            else { pg8::EpiRes<false, true> E{HB, HB, ssq2, nullptr, part, pc}; pg8::gemm_phase<pg8::EpiRes<false, true>, pg8::OneUnit, true, true>(lds, g, S, E, wv0); } } }
    SEAM(5);
    if (IN(6)) REP(6) { if (rep_) grid.sync();
        pg8::Gemm g{Gb, (const bf16_t*)(ws + WS_WDN0), T, D, DFF}; pg8::StaticOrder S; S.init(G >= 64 ? TP : T, D, G, vblk);
        pg8::EpiRes<false> E{HB, HB, ssq2, nullptr};
        pg8::gemm_phase<pg8::EpiRes<false>, pg8::StaticOrder, true, true>(lds, g, S, E, wv0);
    }
    SEAM(6);
    if (IN(7)) REP(7) { if (rep_) grid.sync();
        pg8::Gemm g{HB, (const bf16_t*)(ws + WS_WQKV), T, 3 * D, D}; pg8::StaticOrder S; S.init(T, 3 * D, G, vblk);
        pg8::EpiQKV E{ssq2, R0, R1, R2, out + O_KP, out + O_KS, out + O_VP, out + O_VS, AP()->in[25], AP()->in[21], C2};
        pg8::gemm_phase<pg8::EpiQKV, pg8::StaticOrder, true, true>(lds, g, S, E, wv0);
        { TIDS(); logf_units(AP(), gw, NGW, lane); }
    }
    SEAM(7);
    if (IN(8)) REP(8) { if (rep_) grid.sync();
        TIDS(); LAS float* sh = (LAS float*)lds;
        for (int un = bx; un < NBP * NH + NBS * NH; un += G) {
            if (un < NBP * NH) { const int b = un >> 4, h = un & 15;
                float mg8;
                { float a_ = fabsf(AP()->in[25][lane]), b_ = fabsf(AP()->in[21][lane]);
#pragma unroll
                    for (int o = 1; o < 64; o <<= 1) { a_ = fmaxf(a_, __shfl_xor(a_, o)); b_ = fmaxf(b_, __shfl_xor(b_, o)); }
                    mg8 = 64.f * C2 * a_ * b_ * 1.02f; }
                scan_unit(out + O_LFP + (size_t)b * SEQP * NH + h, SEQP, NH, nullptr, 0, 0, (float*)(ws + WS_CKP) + (size_t)un * SEQP, sh, tid, wave, lane, (int*)(ws + 32768) + un * 32, 2.f * mg8 + 150.f); }
            else { const int us = un - NBP * NH, s = us >> 4, h = us & 15;
                scan_unit(AP()->in[4] + (size_t)s * PAST * NH + h, PAST, NH, out + O_LFS + (size_t)s * SEQS * NH + h, SEQS, NH, (float*)(ws + WS_CKS) + (size_t)us * SKS, sh, tid, wave, lane); }
        }
    }
    SEAM(8);
    if (IN(9)) REP(9) { if (rep_) grid.sync();
        TIDS();
        unsigned* qctr = (unsigned*)ws;
        LAS unsigned* ubox = (LAS unsigned*)(lds + RING_BYTES);
        float mg;
        { const float gq = fabsf(AP()->in[25][lane]), gk = fabsf(AP()->in[21][lane]); float a_ = gq, b_ = gk;
#pragma unroll
            for (int o = 1; o < 64; o <<= 1) { a_ = fmaxf(a_, __shfl_xor(a_, o)); b_ = fmaxf(b_, __shfl_xor(b_, o)); }
            mg = 64.f * C2 * a_ * b_ * 1.02f; }
        constexpr unsigned Q_A = 1024, Q_B = Q_A + 8, Q_C = Q_B + 512, Q_D = Q_C + 44, Q_END = Q_D + 768, Q_S = NBS * NH;
        unsigned* c_attn = (unsigned*)ws + 192; unsigned* c_wo = (unsigned*)ws + 256;
        for (;;) {
            if (wave == 0) ubox[0] = (unsigned)__builtin_amdgcn_readfirstlane((int)__hip_atomic_fetch_add(qctr, lane == 0 ? 1u : 0u, __ATOMIC_RELAXED, __HIP_MEMORY_SCOPE_AGENT));
            __syncthreads();
            const unsigned un = (unsigned)__builtin_amdgcn_readfirstlane((int)ubox[0]);
            __syncthreads();
            if (un >= Q_END) break;
            int v;
            if (un < Q_A) {
                if ((un & 3u) == 0u) { const int su = (int)(un >> 2); int t2 = MYTID(); asm volatile("" : "+v"(t2));
                    attn_sample_unit(AP(), su >> 4, su & 15, lds, t2, __builtin_amdgcn_readfirstlane(t2 >> 6), t2 & 63); ctr_arrive(c_attn, t2); continue; }
                v = (int)(un >> 2) * 3 + (int)(un & 3u) - 1;
            }
            else if (un < Q_B) {
                const int k = (int)(un - Q_A); ctr_wait(c_attn, Q_S, tid);
                pg8::Gemm g{R0, (const bf16_t*)(ws + WS_WO), T, D, D}; pg8::OneUnit S{TP / 256 + (k >> 2), k & 3}; pg8::EpiRes<false> E{HB, HB, ssq3, nullptr};
                pg8::gemm_phase<pg8::EpiRes<false>, pg8::OneUnit, true, true>(lds, g, S, E, wv0);
                ctr_arrive(c_wo, tid); continue; }
            else if (un < Q_C) v = (int)(un - Q_B) + 768;
            else if (un < Q_D) {
                const int k = (int)(un - Q_C); ctr_wait(c_wo, 8u, tid);
                pg8::Gemm g{HB, (const bf16_t*)(ws + WS_WUP1), T, DFF2, D}; pg8::OneUnit S{TP / 256 + k / 22, k % 22};
                pg8::EpiUp<true> E{ssq3, Ab, Gb, (float*)(ws + WS_A), out + O_CONVP + (size_t)NBP * 2 * DFF2, out + O_CONVS + (size_t)NBS * 2 * DFF2, AP()->in[15] + (size_t)3 * DFF2, AP()->in[16] + DFF2};
                pg8::gemm_phase<pg8::EpiUp<true>, pg8::OneUnit, true, true>(lds, g, S, E, wv0);
                continue; }
            else v = (int)(un - Q_D) + 1280;
            const int qb = 31 - (v >> 6), bh = v & 63, q0 = qb * 256;
            const int kt0 = __builtin_amdgcn_readfirstlane(((const int*)(ws + 32768))[bh * 32 + qb]);
            { const f32x4* src = (const f32x4*)((const float*)(ws + WS_CKP) + (size_t)bh * SEQP); LAS f32x4* dst = (LAS f32x4*)(lds + attn_body::LDS_BIAS);
                for (int k = 16 * kt0 + tid; k < (q0 + 256) / 4; k += NTHR) dst[k] = src[k]; }
            __syncthreads();
            attn_body::attn_unit<40>(wv0, bh >> 4, bh & 15, qb, kt0, (const attn_body::bf16*)R0, (const attn_body::bf16*)R1, (const attn_body::bf16*)R2, (attn_body::bf16*)R0, (char*)lds_raw);
        }
    }
    SEAM(9);
    if (IN(10)) REP(10) { if (rep_) grid.sync();
        pg8::Gemm g{R0, (const bf16_t*)(ws + WS_WO), T, D, D}; pg8::StaticOrder S; S.init(TP, D, G, vblk);
        pg8::EpiRes<false> E{HB, HB, ssq3, nullptr};
        pg8::gemm_phase<pg8::EpiRes<false>, pg8::StaticOrder, true, true>(lds, g, S, E, wv0);
    }
    SEAM(10);
    if (IN(11)) REP(11) { if (rep_) grid.sync();
        pg8::Gemm g{HB, (const bf16_t*)(ws + WS_WUP1), T, DFF2, D}; pg8::StaticOrder S; S.init(TP, DFF2, G, vblk);
        pg8::EpiUp<false> E{ssq3, Ab, Gb, (float*)(ws + WS_A), out + O_CONVP + (size_t)NBP * 2 * DFF2, out + O_CONVS + (size_t)NBS * 2 * DFF2, AP()->in[15] + (size_t)3 * DFF2, AP()->in[16] + DFF2};
        pg8::gemm_phase<pg8::EpiUp<false>, pg8::StaticOrder, true, true>(lds, g, S, E, wv0);
    }
    SEAM(11);
    if (IN(12)) REP(12) { if (rep_) grid.sync(); TIDS();
        if (conv_phase(AP(), 1, G, tid, bx, (unsigned*)ws + 128)) {
            const int un_ = bx >> 2, qk = bx & 3, koff = qk < 2 ? qk * 768 : 1536 + (qk - 2) * 640, klen = qk < 2 ? 768 : 640;
            float* part = (float*)(ws + WS_R1) + (size_t)un_ * 3 * 65536; unsigned* pc = (unsigned*)ws + 1088 + 64 * (8 + un_);
            pg8::Gemm g{Gb + koff, (const bf16_t*)(ws + WS_WDN1) + koff, T, D, DFF, klen}; pg8::OneUnit S{TP / 256 + (un_ >> 2), un_ & 3};
            if (qk < 3) { pg8::EpiPart E{part + (size_t)qk * 65536, pc}; pg8::gemm_phase<pg8::EpiPart, pg8::OneUnit, true, true>(lds, g, S, E, wv0); }
            else { pg8::EpiRes<true, true> E{HB, nullptr, nullptr, HF, part, pc}; pg8::gemm_phase<pg8::EpiRes<true, true>, pg8::OneUnit, true, true>(lds, g, S, E, wv0); } } }
    SEAM(12);
    if (IN(13)) REP(13) { if (rep_) grid.sync();
        pg8::Gemm g{Gb, (const bf16_t*)(ws + WS_WDN1), T, D, DFF}; pg8::StaticOrder S; S.init(G >= 64 ? TP : T, D, G, vblk);
        pg8::EpiRes<true> E{HB, nullptr, nullptr, HF};
        pg8::gemm_phase<pg8::EpiRes<true>, pg8::StaticOrder, true, true>(lds, g, S, E, wv0);
    }
#undef IN
#undef SEAM
}

#ifndef MK_N_LAUNCHES
#define MK_N_LAUNCHES 1
#endif
extern "C" void kernel_launch(void* const* d_in, const int* in_sizes, int n_in, void* d_out, int out_size, void* d_ws, size_t ws_size, hipStream_t stream) {
    static int grid = 0;
    if (grid == 0) {
        if (n_in != 27 || (size_t)out_size != O_END || ws_size < WS_END) { fprintf(stderr, "kernel_launch: unexpected shapes (n_in %d out %d ws %zu)\n", n_in, out_size, ws_size); grid = -1; return; }
        int dev = 0, cus = 0, per_cu = 0;
        hipGetDevice(&dev); hipDeviceGetAttribute(&cus, hipDeviceAttributeMultiprocessorCount, dev);
        if (hipFuncSetAttribute((const void*)yoco_fwd, hipFuncAttributeMaxDynamicSharedMemorySize, LDS_BYTES) != hipSuccess) { fprintf(stderr, "kernel_launch: hipFuncSetAttribute failed\n"); grid = -1; return; }
        if (hipOccupancyMaxActiveBlocksPerMultiprocessor(&per_cu, (const void*)yoco_fwd, NTHR, LDS_BYTES) != hipSuccess || per_cu < 1) { fprintf(stderr, "kernel_launch: occupancy query says %d\n", per_cu); per_cu = 1; }
        (void)hipGetLastError();
        grid = cus * 1;
    }
    if (grid < 0) return;
    if (hipMemsetAsync(d_ws, 0, 16384, stream) != hipSuccess) { fprintf(stderr, "kernel_launch: hipMemsetAsync failed\n"); return; }
    Args a{};
    for (int i = 0; i < 27; ++i) a.in[i] = (const float*)d_in[i];
    a.out = (float*)d_out; a.ws = (unsigned char*)d_ws;
    constexpr int NL = MK_N_LAUNCHES;
    for (int li = 0; li < NL; ++li) {
        a.ph_lo = (NL == 1) ? 0 : li; a.ph_hi = (NL == 1) ? NPHASE : li + 1;
        void* kargs[] = {&a};
        hipError_t e = hipLaunchCooperativeKernel((const void*)yoco_fwd, dim3(grid), dim3(NTHR), kargs, LDS_BYTES, stream);
        if (e != hipSuccess) { fprintf(stderr, "kernel_launch: cooperative launch failed: %s (grid %d)\n", hipGetErrorString(e), grid); break; }
    }
}
```

```cpp
#include <hip/hip_runtime.h>
#include <hip/hip_cooperative_groups.h>
#include <cstdio>
#include <cstdint>
namespace pg8 {
#define PG8_LAS __attribute__((address_space(3)))
typedef unsigned short bf16_t;
typedef short bf16x8 __attribute__((ext_vector_type(8)));
typedef float f32x4 __attribute__((ext_vector_type(4)));
typedef unsigned u32x4 __attribute__((ext_vector_type(4)));
constexpr int BM = 256, BK = 64, HALF = 128, HTB = HALF * BK * 2  , STAGE_BYTES = 8 * HTB, NXCD = 8, WGM = 8;

__host__ __device__ __forceinline__ int lds_byte(int r, int c) { const int st = (r >> 4) * 2 + (c >> 5), rr = r & 15, cc = c & 31, ob = rr * 64 + cc * 2; return st * 1024 + (ob ^ (((ob >> 9) & 1) << 5)); }
__host__ __device__ __forceinline__ void stage_rc(int b, int& R, int& C) { const int st = b / 1024, sb = b % 1024, swz = sb ^ (((sb >> 9) & 1) << 5); R = (st >> 1) * 16 + swz / 64; C = (st & 1) * 32 + (swz % 64) / 2; }
__host__ __device__ __forceinline__ int perm32(int rho) { const int n = rho >> 4, i = rho & 15; return 8 * (i >> 2) + 4 * n + (i & 3); }

struct Unit { int pm, pn; };
struct Gemm { const bf16_t* A; const bf16_t* Bt; int M, N, K, KL; };

struct StaticOrder {
    int nM, nN, nwg, G, c;
    __host__ __device__ void init(int M, int N, int G_, int c_) { nM = M / BM; nN = N / BM; nwg = nM * nN; G = G_; c = c_; }
    __host__ __device__ bool next(int i, Unit& u) const {
        const long L = (long)i * G + c; if (L >= nwg) return false;
        int wgid = (int)L; { const int q = nwg / NXCD, r = nwg % NXCD, xcd = wgid % NXCD, off = wgid / NXCD; wgid = (xcd < r ? xcd * (q + 1) : r * (q + 1) + (xcd - r) * q) + off; }
        const int nig = WGM * nN, gid = wgid / nig, fm = gid * WGM, gsz = (nM - fm) < WGM ? (nM - fm) : WGM;
        u.pm = fm + ((wgid % nig) % gsz); u.pn = (wgid % nig) / gsz; return true;
    }
    __device__ __forceinline__ void a_ready(const Unit&) const {}
    __device__ __forceinline__ void done(const Unit&) const {}
};

__device__ __forceinline__ unsigned cvt_pk_bf16(float lo, float hi) { unsigned r; asm volatile("v_cvt_pk_bf16_f32 %0, %1, %2" : "=v"(r) : "v"(lo), "v"(hi)); return r; }
typedef float f32x2 __attribute__((ext_vector_type(2)));
template <class Epi, class Sched, bool ALIGN_EPI = false, bool SP2 = false>
__device__ __forceinline__ void gemm_phase(PG8_LAS unsigned char* lds, const Gemm g, const Sched& S, const Epi& E, const int wv0) {
    int tid_ = (wv0 << 6) | (int)__builtin_amdgcn_mbcnt_hi(~0u, __builtin_amdgcn_mbcnt_lo(~0u, 0u)); asm volatile("" : "+v"(tid_));
    const int tid = tid_, wid = __builtin_amdgcn_readfirstlane(tid >> 6), lane = tid & 63, wr = wid >> 2, wc = wid & 3, fr = lane & 15, fq = lane >> 4;
    const int K = g.K, nt = (g.KL ? g.KL : K) / BK;
    unsigned voffA[2], voffB[2];
#pragma unroll
    for (int i = 0; i < 2; ++i) { int R, C; stage_rc(tid * 16 + i * 8192, R, C); const int Rb = Epi::PERM ? ((R & ~31) + perm32(R & 31)) : R;
        voffA[i] = (unsigned)(R * K + C) * 2u; voffB[i] = (unsigned)(Rb * K + C) * 2u; }
    const size_t kstep = (size_t)(BK * 2);
    const size_t hstep = (size_t)HALF * K * 2;
    const size_t tstep = 2 * hstep;
    const unsigned ldsw = (unsigned)wid * 1024u;
    const int aoff = lds_byte(wr * 64 + fr, fq * 8), boff = lds_byte(wc * 32 + fr, fq * 8);
#define PG8_SA(b, h) (((b) * 2 + (h)) * HTB)
#define PG8_SB(b, h) ((4 + (b) * 2 + (h)) * HTB)
#define PG8_STAGE(bufoff, gbase, voff) do { _Pragma("unroll") for (int _i = 0; _i < 2; ++_i) \
        __builtin_amdgcn_global_load_lds((const unsigned*)((const char*)(gbase) + (voff)[_i]), (PG8_LAS unsigned*)(lds + (bufoff) + ldsw + _i * 8192), 16, 0, 0); } while (0)
#define PG8_LDA(dst, b, h) do { _Pragma("unroll") for (int m = 0; m < 4; ++m) _Pragma("unroll") for (int k = 0; k < 2; ++k) dst[m][k] = *(const PG8_LAS bf16x8*)(lds + PG8_SA(b, h) + aoff + m * 2048 + k * 1024); } while (0)
#define PG8_LDB(dst, b, h) do { _Pragma("unroll") for (int n = 0; n < 2; ++n) _Pragma("unroll") for (int k = 0; k < 2; ++k) dst[n][k] = *(const PG8_LAS bf16x8*)(lds + PG8_SB(b, h) + boff + n * 2048 + k * 1024); } while (0)
#define PG8_MMA(ai, bj, At, Bt) do { __builtin_amdgcn_s_setprio(1); _Pragma("unroll") for (int m = 0; m < 4; ++m) _Pragma("unroll") for (int n = 0; n < 2; ++n) _Pragma("unroll") for (int k = 0; k < 2; ++k) \
        acc[ai][bj][m][n] = __builtin_amdgcn_mfma_f32_16x16x32_bf16(Bt[n][k], At[m][k], acc[ai][bj][m][n], 0, 0, 0); __builtin_amdgcn_s_setprio(0); } while (0)
#define PG8_WAIT_V(n) asm volatile("s_waitcnt vmcnt(" #n ")" ::: "memory")
#define PG8_WAIT_L(n) asm volatile("s_waitcnt lgkmcnt(" #n ")" ::: "memory")
#define PG8_BAR __builtin_amdgcn_s_barrier()
#define PG8_SCHED __builtin_amdgcn_sched_barrier(0)
    Unit cur, nxt; int ui = 0;
    if (!S.next(0, cur)) return;
    f32x4 acc[2][2][4][2];
#pragma unroll
    for (int a = 0; a < 2; ++a)
#pragma unroll
        for (int b = 0; b < 2; ++b)
#pragma unroll
            for (int m = 0; m < 4; ++m)
#pragma unroll
                for (int n = 0; n < 2; ++n) acc[a][b][m][n] = (f32x4){0.f, 0.f, 0.f, 0.f};
    bf16x8 At[4][2], B0[2][2], B1[2][2];
    const char* cA = (const char*)g.A + (size_t)cur.pm * tstep; const char* cB = (const char*)g.Bt + (size_t)cur.pn * tstep;
    S.a_ready(cur);
    if constexpr (SP2) {
        PG8_STAGE(PG8_SB(0, 0), cB, voffB); PG8_STAGE(PG8_SB(0, 1), cB + hstep, voffB); PG8_STAGE(PG8_SA(0, 0), cA, voffA); PG8_STAGE(PG8_SA(0, 1), cA + hstep, voffA);
        if (wr == 1) PG8_BAR;
        PG8_WAIT_V(2); PG8_BAR;
        PG8_STAGE(PG8_SB(1, 0), cB + kstep, voffB); PG8_STAGE(PG8_SA(1, 0), cA + kstep, voffA); PG8_STAGE(PG8_SB(1, 1), cB + hstep + kstep, voffB);
        PG8_WAIT_V(6); PG8_BAR;
    } else {
        PG8_STAGE(PG8_SB(0, 0), cB, voffB); PG8_STAGE(PG8_SA(0, 0), cA, voffA); PG8_STAGE(PG8_SB(0, 1), cB + hstep, voffB); PG8_STAGE(PG8_SA(0, 1), cA + hstep, voffA);
        if (wr == 1) PG8_BAR;
        PG8_WAIT_V(4); PG8_BAR;
        PG8_STAGE(PG8_SB(1, 0), cB + kstep, voffB); PG8_STAGE(PG8_SA(1, 0), cA + kstep, voffA); PG8_STAGE(PG8_SB(1, 1), cB + hstep + kstep, voffB);
        PG8_WAIT_V(6); PG8_BAR;
    }
    for (;;) {
        const bool has_next = S.next(ui + 1, nxt);
        const char* nA = has_next ? (const char*)g.A + (size_t)nxt.pm * tstep : cA; const char* nB = has_next ? (const char*)g.Bt + (size_t)nxt.pn * tstep : cB;
        for (int t = 0; t < nt; t += 2) {
            const bool last = (t == nt - 2);
            const char* a1 = cA + (size_t)(t + 1) * kstep;
            const char* a2 = last ? nA : cA + (size_t)(t + 2) * kstep; const char* b2 = last ? nB : cB + (size_t)(t + 2) * kstep;
            const char* a3 = a2 + kstep; const char* b3 = b2 + kstep;
            if (last && has_next) S.a_ready(nxt);
            if constexpr (SP2) {
            PG8_LDB(B0, 0, 0); PG8_LDB(B1, 0, 1); PG8_SCHED; PG8_LDA(At, 0, 0); PG8_STAGE(PG8_SA(1, 1), a1 + hstep, voffA);
            PG8_WAIT_V(8); PG8_WAIT_L(0); PG8_BAR; PG8_MMA(0, 0, At, B0); PG8_MMA(0, 1, At, B1); PG8_BAR; PG8_SCHED;
            PG8_LDA(At, 0, 1); PG8_STAGE(PG8_SB(0, 0), b2, voffB); PG8_STAGE(PG8_SB(0, 1), b2 + hstep, voffB); PG8_STAGE(PG8_SA(0, 0), a2, voffA);
            PG8_WAIT_V(8); PG8_WAIT_L(0); PG8_BAR; PG8_MMA(1, 0, At, B0); PG8_MMA(1, 1, At, B1); PG8_BAR; PG8_SCHED;
            PG8_LDB(B0, 1, 0); PG8_LDB(B1, 1, 1); PG8_SCHED; PG8_LDA(At, 1, 0); PG8_STAGE(PG8_SA(0, 1), a2 + hstep, voffA);
            PG8_WAIT_V(8); PG8_WAIT_L(0); PG8_BAR; PG8_MMA(0, 0, At, B0); PG8_MMA(0, 1, At, B1); PG8_BAR; PG8_SCHED;
            PG8_LDA(At, 1, 1); PG8_STAGE(PG8_SB(1, 0), b3, voffB); PG8_STAGE(PG8_SB(1, 1), b3 + hstep, voffB); PG8_STAGE(PG8_SA(1, 0), a3, voffA);
            PG8_WAIT_V(8); PG8_WAIT_L(0); PG8_BAR; PG8_MMA(1, 0, At, B0); PG8_MMA(1, 1, At, B1); PG8_BAR; PG8_SCHED;
            } else {
            PG8_LDB(B0, 0, 0); PG8_SCHED; PG8_LDA(At, 0, 0); PG8_STAGE(PG8_SA(1, 1), a1 + hstep, voffA);
            PG8_WAIT_L(8); PG8_BAR; PG8_WAIT_L(0); PG8_MMA(0, 0, At, B0); PG8_BAR; PG8_SCHED;
            PG8_LDB(B1, 0, 1); PG8_STAGE(PG8_SB(0, 0), b2, voffB);
            PG8_BAR; PG8_WAIT_L(0); PG8_MMA(0, 1, At, B1); PG8_BAR;
            PG8_LDA(At, 0, 1); PG8_STAGE(PG8_SA(0, 0), a2, voffA);
            PG8_BAR; PG8_WAIT_L(0); PG8_MMA(1, 0, At, B0); PG8_BAR; PG8_SCHED;
            PG8_STAGE(PG8_SB(0, 1), b2 + hstep, voffB);
            PG8_WAIT_V(6); PG8_BAR; PG8_MMA(1, 1, At, B1); PG8_BAR;
            PG8_LDB(B0, 1, 0); PG8_SCHED; PG8_LDA(At, 1, 0); PG8_STAGE(PG8_SA(0, 1), a2 + hstep, voffA);
            PG8_WAIT_L(8); PG8_BAR; PG8_WAIT_L(0); PG8_MMA(0, 0, At, B0); PG8_BAR; PG8_SCHED;
            PG8_LDB(B1, 1, 1); PG8_STAGE(PG8_SB(1, 0), b3, voffB);
            PG8_BAR; PG8_WAIT_L(0); PG8_MMA(0, 1, At, B1); PG8_BAR;
            PG8_LDA(At, 1, 1); PG8_STAGE(PG8_SA(1, 0), a3, voffA);
            PG8_BAR; PG8_WAIT_L(0); PG8_MMA(1, 0, At, B0); PG8_BAR; PG8_SCHED;
            PG8_STAGE(PG8_SB(1, 1), b3 + hstep, voffB);
            PG8_WAIT_V(6); PG8_BAR; PG8_MMA(1, 1, At, B1); PG8_BAR;
            }
        }
        if constexpr (ALIGN_EPI) { if (wr == 0) PG8_BAR; }
        if constexpr (!Epi::AFTER_DRAIN) { E(acc, cur, wr, wc, fr, fq); S.done(cur); }
        if (!has_next) break;
#pragma unroll
        for (int a = 0; a < 2; ++a)
#pragma unroll
            for (int b = 0; b < 2; ++b)
#pragma unroll
                for (int m = 0; m < 4; ++m)
#pragma unroll
                    for (int n = 0; n < 2; ++n) acc[a][b][m][n] = (f32x4){0.f, 0.f, 0.f, 0.f};
        cur = nxt; cA = nA; cB = nB; ++ui;
        if constexpr (ALIGN_EPI) { if (wr == 1) PG8_BAR; }
    }
    PG8_WAIT_V(0);
    if constexpr (!ALIGN_EPI) { if (wr == 0) PG8_BAR; }
    PG8_BAR;
    if constexpr (Epi::AFTER_DRAIN) { E.fused(acc, cur, wr, wc, fr, fq, lds, wid, lane); S.done(cur); }
#undef PG8_SA
#undef PG8_SB
#undef PG8_STAGE
#undef PG8_LDA
#undef PG8_LDB
#undef PG8_MMA
#undef PG8_WAIT_V
#undef PG8_WAIT_L
#undef PG8_BAR
#undef PG8_SCHED
}
}
namespace pg8 {
constexpr int TP = 32768;
constexpr float RMS_EPS = 1e-6f;
typedef unsigned u32x2 __attribute__((ext_vector_type(2)));
__device__ __forceinline__ float quad_sum(float s) { s += __shfl_xor(s, 16); s += __shfl_xor(s, 32); return s; }
__device__ __forceinline__ float row_rstd(const float* ssq, int row, int fq) {
    const f32x4 p = *(const f32x4*)(ssq + (size_t)row * 16 + 4 * fq);
    const float s = quad_sum((p[0] + p[1]) + (p[2] + p[3]));
    return __builtin_amdgcn_rsqf(s * (1.0f / 1024.0f) + RMS_EPS);
}
__device__ __forceinline__ void rows_rstd(float (&rs)[2][4], const float* ssq, int rowb, int fq) {
#pragma unroll
    for (int ai = 0; ai < 2; ++ai) {
        f32x4 p[4];
#pragma unroll
        for (int m = 0; m < 4; ++m) p[m] = *(const f32x4*)(ssq + (size_t)(rowb + ai * HALF + m * 16) * 16 + 4 * fq);
#pragma unroll
        for (int m = 0; m < 4; ++m) { const float s = quad_sum((p[m][0] + p[m][1]) + (p[m][2] + p[m][3])); rs[ai][m] = __builtin_amdgcn_rsqf(s * (1.0f / 1024.0f) + RMS_EPS); }
        __builtin_amdgcn_sched_barrier(0);
    }
}
__device__ __forceinline__ float gelu_tanh(float x) {
    const float y = 0.7978845608028654f * (x + 0.044715f * x * x * x);
    return x * __builtin_amdgcn_rcpf(1.0f + __builtin_amdgcn_exp2f(-2.8853900817779268f * y));
}
__device__ __forceinline__ u32x2 pack4(const f32x4 v) { u32x2 w; w.x = cvt_pk_bf16(v[0], v[1]); w.y = cvt_pk_bf16(v[2], v[3]); return w; }

struct EpiSguIn {
    static constexpr bool PERM = false, AFTER_DRAIN = false;
    const float* ssq; bf16_t* U; bf16_t* VP; float* vstat;
    __device__ __forceinline__ void operator()(const f32x4 (&acc)[2][2][4][2], const Unit& u, int wr, int wc, int fr, int fq) const {
        const bool isv = u.pn >= 4; bf16_t* O = isv ? +VP : +U; const int col0 = (u.pn & 3) * BM + wc * 32 + 4 * fq;
        float rsv[2][4]; rows_rstd(rsv, ssq, u.pm * BM + wr * 64 + fr, fq);
#pragma unroll
        for (int ai = 0; ai < 2; ++ai)
#pragma unroll
            for (int m = 0; m < 4; ++m) {
                const int row = u.pm * BM + ai * HALF + wr * 64 + m * 16 + fr; const float rstd = rsv[ai][m];
                float s = 0.f, s2 = 0.f; bf16_t* rowp = O + (size_t)row * 1024 + col0;
#pragma unroll
                for (int bj = 0; bj < 2; ++bj)
#pragma unroll
                    for (int n = 0; n < 2; ++n) { f32x4 v = acc[ai][bj][m][n] * rstd;
                        v[0] = gelu_tanh(v[0]); v[1] = gelu_tanh(v[1]); v[2] = gelu_tanh(v[2]); v[3] = gelu_tanh(v[3]);
                        s += (v[0] + v[1]) + (v[2] + v[3]); s2 += (v[0] * v[0] + v[1] * v[1]) + (v[2] * v[2] + v[3] * v[3]);
                        *(u32x2*)(rowp + bj * HALF + n * 16) = pack4(v); }
                if (isv) { s = quad_sum(s); s2 = quad_sum(s2);
                    if (fq == 0) { float* p = vstat + ((size_t)row * 16 + (u.pn - 4) * 4 + wc) * 2; p[0] = s; p[1] = s2; } }
            }
    }
};
__device__ __forceinline__ void part_arrive(unsigned* ctr, int tid) {
    asm volatile("s_waitcnt vmcnt(0)" ::: "memory"); __syncthreads();
    if (__builtin_amdgcn_readfirstlane(tid >> 6) == 0) { __builtin_amdgcn_fence(__ATOMIC_RELEASE, "agent"); asm volatile("s_waitcnt vmcnt(0)" ::: "memory");
        __hip_atomic_fetch_add(ctr, (tid & 63) == 0 ? 1u : 0u, __ATOMIC_RELAXED, __HIP_MEMORY_SCOPE_AGENT); }
}
__device__ __forceinline__ void part_wait(unsigned* ctr, unsigned need, int tid) {
    if (__builtin_amdgcn_readfirstlane(tid >> 6) == 0) {
        while ((unsigned)__builtin_amdgcn_readfirstlane((int)__hip_atomic_load(ctr, __ATOMIC_RELAXED, __HIP_MEMORY_SCOPE_AGENT)) < need) __builtin_amdgcn_s_sleep(2);
        __builtin_amdgcn_fence(__ATOMIC_ACQUIRE, "agent"); asm volatile("s_waitcnt vmcnt(0)" ::: "memory"); }
    __syncthreads();
}
struct EpiPart {
    static constexpr bool PERM = true, AFTER_DRAIN = false;
    float* part; unsigned* ctr;
    __device__ __forceinline__ void operator()(const f32x4 (&acc)[2][2][4][2], const Unit&, int wr, int wc, int fr, int fq) const {
        const int tid = ((wr * 4 + wc) << 6) | (fq * 16 + fr); f32x4* p = (f32x4*)part + tid;
#pragma unroll
        for (int ai = 0; ai < 2; ++ai)
#pragma unroll
            for (int bj = 0; bj < 2; ++bj)
#pragma unroll
                for (int m = 0; m < 4; ++m)
#pragma unroll
                    for (int n = 0; n < 2; ++n) p[(((ai * 2 + bj) * 4 + m) * 2 + n) * 512] = acc[ai][bj][m][n];
        part_arrive(ctr, tid);
    }
};
__device__ __forceinline__ void add_partials(const f32x4 (&acc)[2][2][4][2], const float* part, unsigned* ctr, int wr, int wc, int fr, int fq) {
    const int tid = ((wr * 4 + wc) << 6) | (fq * 16 + fr); part_wait(ctr, 3u, tid); asm volatile("" ::: "memory"); __builtin_amdgcn_sched_barrier(0);
    f32x4 (&ac)[2][2][4][2] = const_cast<f32x4 (&)[2][2][4][2]>(acc);
#pragma unroll 1
    for (int pk = 2; pk >= 0; --pk) {
        const f32x4* p = (const f32x4*)part + (size_t)pk * 16384 + tid;
#pragma unroll
        for (int ai = 0; ai < 2; ++ai)
#pragma unroll
            for (int bj = 0; bj < 2; ++bj)
#pragma unroll
                for (int m = 0; m < 4; ++m)
#pragma unroll
                    for (int n = 0; n < 2; ++n) { ac[ai][bj][m][n] = p[(((ai * 2 + bj) * 4 + m) * 2 + n) * 512] + ac[ai][bj][m][n];
                        if (n == 1 && (m & 1)) { asm volatile("" : "+v"(ac[ai][bj][m - 1][0]), "+v"(ac[ai][bj][m - 1][1]), "+v"(ac[ai][bj][m][0]), "+v"(ac[ai][bj][m][1]) :: "memory"); __builtin_amdgcn_sched_barrier(0); } }
    }
}
template <bool FINAL, bool PART = false> struct EpiRes {
    static constexpr bool PERM = true, AFTER_DRAIN = false;
    const bf16_t* hin; bf16_t* hb; float* ssq; float* yout;
    const float* part; unsigned* ctr;
    __device__ __forceinline__ void operator()(const f32x4 (&acc)[2][2][4][2], const Unit& u, int wr, int wc, int fr, int fq) const {
        if constexpr (PART) add_partials(acc, part, ctr, wr, wc, fr, fq);
        const int col0 = u.pn * BM + wc * 32 + 8 * fq, rowb = u.pm * BM + wr * 64 + fr;
        u32x4 pre[3][2];
#define EPIRES_LOAD(g, buf) do { const bf16_t* hi_ = hin + (size_t)(rowb + ((g) >> 2) * HALF + ((g) & 3) * 16) * 1024 + col0; \
            pre[buf][0] = *(const u32x4*)(hi_); pre[buf][1] = *(const u32x4*)(hi_ + HALF); } while (0)
        EPIRES_LOAD(0, 0); EPIRES_LOAD(1, 1);
#pragma unroll
        for (int g = 0; g < 8; ++g) {
            if (g + 2 < 8) EPIRES_LOAD(g + 2, (g + 2) % 3);
            const int ai = g >> 2, m = g & 3, row = rowb + ai * HALF + m * 16; float s2 = 0.f;
#pragma unroll
            for (int bj = 0; bj < 2; ++bj) { const u32x4 r = pre[g % 3][bj];
                const f32x4 v0 = acc[ai][bj][m][0] + (f32x4){__uint_as_float(r.x << 16), __uint_as_float(r.x & 0xffff0000u), __uint_as_float(r.y << 16), __uint_as_float(r.y & 0xffff0000u)};
                const f32x4 v1 = acc[ai][bj][m][1] + (f32x4){__uint_as_float(r.z << 16), __uint_as_float(r.z & 0xffff0000u), __uint_as_float(r.w << 16), __uint_as_float(r.w & 0xffff0000u)};
                if (FINAL) { float* yo = yout + (size_t)row * 1024 + col0 + bj * HALF; __builtin_nontemporal_store(v0, (f32x4*)yo); __builtin_nontemporal_store(v1, (f32x4*)(yo + 4)); }
                else { u32x4 w; w.x = cvt_pk_bf16(v0[0], v0[1]); w.y = cvt_pk_bf16(v0[2], v0[3]); w.z = cvt_pk_bf16(v1[0], v1[1]); w.w = cvt_pk_bf16(v1[2], v1[3]);
                    *(u32x4*)(hb + (size_t)row * 1024 + col0 + bj * HALF) = w;
                    s2 += ((v0[0] * v0[0] + v0[1] * v0[1]) + (v0[2] * v0[2] + v0[3] * v0[3])) + ((v1[0] * v1[0] + v1[1] * v1[1]) + (v1[2] * v1[2] + v1[3] * v1[3])); } }
            if (!FINAL) { s2 = quad_sum(s2); if (fq == 0) ssq[(size_t)row * 16 + u.pn * 4 + wc] = s2; }
        }
#undef EPIRES_LOAD
    }
};
template <int S> __device__ __forceinline__ float dpp_prev(float prevm, float cur) {
    const int o = __builtin_amdgcn_update_dpp(0, __builtin_bit_cast(int, prevm), 0x120 + S, 0xf, 0xf, true);
    return __builtin_bit_cast(float, __builtin_amdgcn_update_dpp(o, __builtin_bit_cast(int, cur), 0x110 + S, 0xf, 0xf, false));
}
template <int S> __device__ __forceinline__ float dpp_first(float cur) {
    return __builtin_bit_cast(float, __builtin_amdgcn_update_dpp(0, __builtin_bit_cast(int, cur), 0x110 + S, 0xf, 0xf, true));
}
template <bool SAMPLE> struct EpiUp {
    static constexpr bool PERM = false, AFTER_DRAIN = false;
    const float* ssq; bf16_t* A; bf16_t* Gout; float* stash; float* convP; float* convS; const float* cw; const float* cb;
    __device__ __forceinline__ void operator()(const f32x4 (&acc)[2][2][4][2], const Unit& u, int wr, int wc, int fr, int fq) const {
        float rsv[2][4]; rows_rstd(rsv, ssq, u.pm * BM + wr * 64 + fr, fq);
        const int cbase = u.pn * 128 + wc * 32 + 4 * fq;
        if constexpr (SAMPLE) {
#pragma unroll
            for (int ai = 0; ai < 2; ++ai)
#pragma unroll
                for (int m = 0; m < 4; ++m) {
                    const int row = u.pm * BM + ai * HALF + wr * 64 + m * 16 + fr; const float rstd = rsv[ai][m];
                    float* tp = nullptr; { const int rs = row - TP, t = rs & 31; if (t >= 30) tp = convS + (size_t)((rs >> 5) * 2 + (t - 30)) * 5632; }
                    bf16_t* ap = A + (size_t)row * 5632;
#pragma unroll
                    for (int bj = 0; bj < 2; ++bj)
#pragma unroll
                        for (int n = 0; n < 2; ++n) { const f32x4 v = acc[ai][bj][m][n] * rstd; const int cl = bj * 2816 + cbase + 16 * n; *(u32x2*)(ap + cl) = pack4(v);
                            if (tp) *(f32x4*)(tp + cl) = v; }
                }
        } else {
        typedef float f32x2v __attribute__((ext_vector_type(2)));
        f32x2v wc_[8], wn_[8];
#define UPW_LOAD(dst, gi_) do { const int Jh_ = cbase + 16 * ((gi_) >> 1) + 2 * ((gi_) & 1); \
            dst[0] = *(const f32x2v*)(cw + Jh_); dst[1] = *(const f32x2v*)(cw + 5632 + Jh_); dst[2] = *(const f32x2v*)(cw + 2 * 5632 + Jh_); dst[3] = *(const f32x2v*)(cb + Jh_); \
            dst[4] = *(const f32x2v*)(cw + 2816 + Jh_); dst[5] = *(const f32x2v*)(cw + 5632 + 2816 + Jh_); dst[6] = *(const f32x2v*)(cw + 2 * 5632 + 2816 + Jh_); dst[7] = *(const f32x2v*)(cb + 2816 + Jh_); } while (0)
        UPW_LOAD(wc_, 0);
        f32x4 (&ac)[2][2][4][2] = const_cast<f32x4 (&)[2][2][4][2]>(acc);
#pragma unroll
        for (int ai = 0; ai < 2; ++ai)
#pragma unroll
            for (int m = 0; m < 4; ++m)
#pragma unroll
                for (int bj = 0; bj < 2; ++bj)
#pragma unroll
                    for (int n = 0; n < 2; ++n) ac[ai][bj][m][n] = ac[ai][bj][m][n] * rsv[ai][m];
        asm volatile("" ::: "memory"); __builtin_amdgcn_sched_barrier(0);
        unsigned pk0[2][4];
#pragma unroll
        for (int gi = 0; gi < 4; ++gi) {
            const int n = gi >> 1, jh = gi & 1, J = cbase + 16 * n;
            const f32x2v w0g = wc_[0], w1g = wc_[1], w2g = wc_[2], bg = wc_[3], w0v = wc_[4], w1v = wc_[5], w2v = wc_[6], bv = wc_[7];
#pragma unroll
            for (int ai = 0; ai < 2; ++ai) {
                if (ai == 1 && gi < 3) UPW_LOAD(wn_, gi + 1);
#pragma unroll
                for (int m = 0; m < 4; ++m) {
                    const int row = u.pm * BM + ai * HALF + wr * 64 + m * 16 + fr;
                    float og[2];
#pragma unroll
                    for (int e = 0; e < 2; ++e) {
                        const float xg = ac[ai][0][m][n][2 * jh + e], xv = ac[ai][1][m][n][2 * jh + e];
                        float g1, g2, v1, v2;
                        if (m == 0) { g1 = dpp_first<1>(xg); g2 = dpp_first<2>(xg); v1 = dpp_first<1>(xv); v2 = dpp_first<2>(xv); }
                        else { const float pg = ac[ai][0][m ? m - 1 : 0][n][2 * jh + e], pv = ac[ai][1][m ? m - 1 : 0][n][2 * jh + e];
                            g1 = dpp_prev<1>(pg, xg); g2 = dpp_prev<2>(pg, xg); v1 = dpp_prev<1>(pv, xv); v2 = dpp_prev<2>(pv, xv); }
                        const float cg = xg * w2g[e] + g1 * w1g[e] + g2 * w0g[e] + bg[e], cv = xv * w2v[e] + v1 * w1v[e] + v2 * w0v[e] + bv[e];
                        og[e] = cg * __builtin_amdgcn_rcpf(1.0f + __builtin_amdgcn_exp2f(-1.4426950408889634f * cg)) * cv;
                    }
                    const unsigned pk = cvt_pk_bf16(og[0], og[1]);
                    if (jh == 0) pk0[ai][m] = pk;
                    else {
                        if (!(m == 0 && fr < 2)) { u32x2 w; w.x = pk0[ai][m]; w.y = pk; *(u32x2*)(Gout + (size_t)row * 2816 + J) = w; }
                        if ((m == 0 && fr < 2) || (m == 3 && fr >= 14)) {
                            const f32x4 xg4 = ac[ai][0][m][n], xv4 = ac[ai][1][m][n];
                            float* sp = stash + (((size_t)(row >> 6) * 4 + (m == 0 ? fr : fr - 12)) * 2) * 2816 + J; *(f32x4*)sp = xg4; *(f32x4*)(sp + 2816) = xv4;
                            if (m == 3 && (row & 8191) >= 8190) { float* tp = convP + (size_t)((row >> 13) * 2 + ((row & 8191) - 8190)) * 5632; *(f32x4*)(tp + J) = xg4; *(f32x4*)(tp + 2816 + J) = xv4; } }
                    }
                    asm volatile("" ::: "memory"); __builtin_amdgcn_sched_barrier(0);
                }
            }
#pragma unroll
            for (int k = 0; k < 8; ++k) wc_[k] = wn_[k];
        }
#undef UPW_LOAD
        }
    }
};
struct EpiQKV {
    static constexpr bool PERM = false, AFTER_DRAIN = false;
    const float* ssq; bf16_t* Q; bf16_t* K; bf16_t* V; float* koP; float* koS; float* voP; float* voS; const float* qg; const float* kg; float c2;
    __device__ __forceinline__ void operator()(const f32x4 (&acc)[2][2][4][2], const Unit& u, int wr, int wc, int fr, int fq) const {
        const int t = u.pn >> 2, head = (u.pn & 3) * 4 + wc, colh = head * 64 + 4 * fq;
        const float* qg_ = qg; const float* kg_ = kg; bf16_t* Q_ = Q; bf16_t* K_ = K; bf16_t* V_ = V;
        asm volatile("" : "+s"(qg_), "+s"(kg_), "+s"(Q_), "+s"(K_), "+s"(V_));
        f32x4 gv[2][2];
#pragma unroll
        for (int bj = 0; bj < 2; ++bj)
#pragma unroll
            for (int n = 0; n < 2; ++n) gv[bj][n] = (t < 2) ? *(const f32x4*)((t == 0 ? qg_ : kg_) + 32 * bj + 16 * n + 4 * fq) : (f32x4){1.f, 1.f, 1.f, 1.f};
        bf16_t* B = t == 0 ? Q_ : (t == 1 ? K_ : V_);
        float rsv[2][4]; rows_rstd(rsv, ssq, u.pm * BM + wr * 64 + fr, fq);
#pragma unroll
        for (int ai = 0; ai < 2; ++ai)
#pragma unroll
            for (int m = 0; m < 4; ++m) {
                const int row = u.pm * BM + ai * HALF + wr * 64 + m * 16 + fr; const float rstd = rsv[ai][m];
                f32x4 v[2][2]; float ss = 0.f;
#pragma unroll
                for (int bj = 0; bj < 2; ++bj)
#pragma unroll
                    for (int n = 0; n < 2; ++n) { v[bj][n] = acc[ai][bj][m][n] * rstd; const f32x4 x = v[bj][n]; ss += (x[0] * x[0] + x[1] * x[1]) + (x[2] * x[2] + x[3] * x[3]); }
                float rs = 1.f;
                if (t < 2) { ss = quad_sum(ss); rs = __builtin_amdgcn_rsqf(ss * (1.0f / 64.0f) + RMS_EPS); if (t == 0) rs *= c2; }
                float* fo = nullptr;
                if (t == 1) fo = (row < TP ? koP + (size_t)row * 1024 : koS + (size_t)(row - TP) * 1024) + colh;
                if (t == 2) fo = (row < TP ? voP + (size_t)row * 1024 : voS + (size_t)(row - TP) * 1024) + colh;
                bf16_t* bo = B + (size_t)row * 1024 + colh;
#pragma unroll
                for (int bj = 0; bj < 2; ++bj)
#pragma unroll
                    for (int n = 0; n < 2; ++n) { const f32x4 o = v[bj][n] * rs * gv[bj][n]; *(u32x2*)(bo + 32 * bj + 16 * n) = pack4(o);
                        if (fo) __builtin_nontemporal_store(o, (f32x4*)(fo + 32 * bj + 16 * n)); }
            }
    }
};
struct OneUnit { int pm, pn;
    __device__ __forceinline__ bool next(int i, Unit& u) const { if (i != 0) return false; u.pm = pm; u.pn = pn; return true; }
    __device__ __forceinline__ void a_ready(const Unit&) const {}
    __device__ __forceinline__ void done(const Unit&) const {}
};
}
#include <hip/hip_bf16.h>
#include <cmath>
namespace attn_body {
using bf16=__hip_bfloat16;
using bf16x8=__attribute__((ext_vector_type(8)))short;
using s16x4=__attribute__((ext_vector_type(4)))short;
using f32x16=__attribute__((ext_vector_type(16)))float;
using u32x4=__attribute__((ext_vector_type(4)))unsigned;
constexpr int BATCH=4,NHEAD=16,SEQ=8192,D=64,DM=NHEAD*D;
constexpr int NW=8,QBLK=32,QB=QBLK*NW,KVBLK=64,NQB=SEQ/QB;
constexpr int ATTN_PITCH=DM, ATTN_UNIT_ROWS=QB;
__device__ __forceinline__ int crow(int r,int hi){return (r&3)+8*(r>>2)+4*hi;}
#define SBAR() __builtin_amdgcn_sched_barrier(0)
__device__ __forceinline__ void cmask(f32x16&p0,f32x16&p1,int jb,int qrel,int hi){
  const float NEG=-INFINITY; int kb=64*jb+4*hi;
  #pragma unroll
  for(int r=0;r<16;++r){int kv=kb+(r&3)+8*(r>>2); if(kv>qrel)p0[r]=NEG; if(kv+32>qrel)p1[r]=NEG;}
}

constexpr int NSLOT=3, SLOTB=8192, LDS_BIAS=86016;
constexpr int LDS_K=0, LDS_V=NSLOT*SLOTB, LDS_WS=2*NSLOT*SLOTB, LDS_OST=LDS_WS+NW*64*4, LDS_BYTES=LDS_OST+NW*4096;
constexpr float C2=0.125f*1.4426950408889634f;
__device__ __forceinline__ void glds16(const void*gsrc,unsigned lds_dst){unsigned keep;
  asm volatile("s_mov_b32 %0, m0\n\ts_mov_b32 m0, %2\n\ts_nop 0\n\tglobal_load_lds_dwordx4 %1, off\n\ts_mov_b32 m0, %0":"=&s"(keep):"v"(gsrc),"s"(lds_dst):"memory");}
__device__ __forceinline__ float max3f(float a,float b,float c){float r;asm("v_max3_f32 %0, %1, %2, %3":"=v"(r):"v"(a),"v"(b),"v"(c));return r;}
__device__ __forceinline__ float max2f(float a,float b){float r;asm("v_max_f32_e32 %0, %1, %2":"=v"(r):"v"(a),"v"(b));return r;}
__device__ __forceinline__ float fadd_s(float a,float b){float r;asm("v_add_f32_e32 %0, %1, %2":"=v"(r):"v"(a),"v"(b));return r;}
__device__ __forceinline__ float fsub_s(float a,float b){float r;asm("v_sub_f32_e32 %0, %1, %2":"=v"(r):"v"(a),"v"(b));return r;}
typedef float f32x2_t __attribute__((ext_vector_type(2))); typedef __bf16 bf16x2_t __attribute__((ext_vector_type(2)));
__device__ __forceinline__ unsigned cvtpk_s(float lo,float hi){f32x2_t v={lo,hi};bf16x2_t b=__builtin_convertvector(v,bf16x2_t);return __builtin_bit_cast(unsigned,b);}
#define WAIT_BAR(N) asm volatile("s_waitcnt vmcnt(" #N ") lgkmcnt(0)\n\ts_barrier":::"memory")

__device__ __forceinline__ void qkt(f32x16&p0,f32x16&p1,const char*Kslot,const bf16x8*qr,int r32,int hi){
  const char*kb=Kslot+hi*1024+r32*16;
  #pragma unroll
  for(int d0=0;d0<4;++d0){
    const bf16x8 b0=*reinterpret_cast<const bf16x8*>(kb+d0*2048);
    const bf16x8 b1=*reinterpret_cast<const bf16x8*>(kb+d0*2048+512);
    if(d0==0){p0=__builtin_amdgcn_mfma_f32_32x32x16_bf16(b0,qr[0],p0,0,0,0);p1=__builtin_amdgcn_mfma_f32_32x32x16_bf16(b1,qr[0],p1,0,0,0);}
    else{p0=__builtin_amdgcn_mfma_f32_32x32x16_bf16(b0,qr[d0],p0,0,0,0);p1=__builtin_amdgcn_mfma_f32_32x32x16_bf16(b1,qr[d0],p1,0,0,0);}}
}
typedef __attribute__((address_space(3))) const char* lds_cptr;
typedef short v4i16_t __attribute__((ext_vector_type(4)));
__device__ __forceinline__ void kload8(bf16x8*kf,lds_cptr kp){
  kf[0]=*(const __attribute__((address_space(3))) bf16x8*)(kp);      kf[1]=*(const __attribute__((address_space(3))) bf16x8*)(kp+512);
  kf[2]=*(const __attribute__((address_space(3))) bf16x8*)(kp+2048); kf[3]=*(const __attribute__((address_space(3))) bf16x8*)(kp+2560);
  kf[4]=*(const __attribute__((address_space(3))) bf16x8*)(kp+4096); kf[5]=*(const __attribute__((address_space(3))) bf16x8*)(kp+4608);
  kf[6]=*(const __attribute__((address_space(3))) bf16x8*)(kp+6144); kf[7]=*(const __attribute__((address_space(3))) bf16x8*)(kp+6656);
}
__device__ __forceinline__ void kload2(bf16x8*kf,lds_cptr kp,int j){ kf[2*j]=*(const __attribute__((address_space(3))) bf16x8*)(kp+j*2048); kf[2*j+1]=*(const __attribute__((address_space(3))) bf16x8*)(kp+j*2048+512); }
__device__ __forceinline__ s16x4 vtr(lds_cptr p){ return __builtin_bit_cast(s16x4,__builtin_amdgcn_ds_read_tr16_b64_v4i16((__attribute__((address_space(3))) v4i16_t*)p)); }
__device__ __forceinline__ float rowmax(const f32x16&p0,const f32x16&p1){
  float a=max3f(p0[0],p0[1],p1[0]),b=max3f(p0[2],p0[3],p1[1]);a=max3f(a,p1[2],p1[3]);
  #pragma unroll
  for(int r=4;r<16;r+=4){a=max3f(a,p0[r],p0[r+1]);b=max3f(b,p0[r+2],p0[r+3]);a=max3f(a,p1[r],p1[r+1]);b=max3f(b,p1[r+2],p1[r+3]);}
  const float m=max2f(a,b);
  auto rr=__builtin_amdgcn_permlane32_swap(__float_as_uint(m),__float_as_uint(m),false,false);
  return max2f(__uint_as_float(rr[0]),__uint_as_float(rr[1]));
}
__device__ __forceinline__ void pv(f32x16*o,int vb,bf16x8 pa0,bf16x8 pa1,bf16x8 pa2,bf16x8 pa3){
  #pragma unroll
  for(int d0=0;d0<2;++d0){s16x4 lo[4],hi[4];
    #pragma unroll
    for(int ks=0;ks<4;++ks){
      asm volatile("ds_read_b64_tr_b16 %0,%1 offset:%c2":"=&v"(lo[ks]):"v"(vb),"i"(d0*4096+ks*1024):"memory");
      asm volatile("ds_read_b64_tr_b16 %0,%1 offset:%c2":"=&v"(hi[ks]):"v"(vb),"i"(d0*4096+ks*1024+512):"memory");}
    asm volatile("s_waitcnt lgkmcnt(0)":::"memory");SBAR();
    #define PK(k) (bf16x8){lo[k][0],lo[k][1],lo[k][2],lo[k][3],hi[k][0],hi[k][1],hi[k][2],hi[k][3]}
    o[d0]=__builtin_amdgcn_mfma_f32_32x32x16_bf16(pa0,PK(0),o[d0],0,0,0);
    o[d0]=__builtin_amdgcn_mfma_f32_32x32x16_bf16(pa1,PK(1),o[d0],0,0,0);
    o[d0]=__builtin_amdgcn_mfma_f32_32x32x16_bf16(pa2,PK(2),o[d0],0,0,0);
    o[d0]=__builtin_amdgcn_mfma_f32_32x32x16_bf16(pa3,PK(3),o[d0],0,0,0);
    #undef PK
  }
}

#ifndef ATTN_STORE16
#define ATTN_STORE16(p,v) (*(u32x4*)(p)=(v))
#endif
template<int THRL> __device__ __forceinline__ void attn_unit(int wv0,int b,int h,int qb,int kt0,const bf16*Q,const bf16*__restrict__ K,const bf16*__restrict__ V,bf16*O,char*shm){
  int tid_=(wv0<<6)|(int)__builtin_amdgcn_mbcnt_hi(~0u,__builtin_amdgcn_mbcnt_lo(~0u,0u)); asm volatile("":"+v"(tid_)); const int tid=tid_,lane=tid&63,r32=lane&31,hi=lane>>5; const int wid=__builtin_amdgcn_readfirstlane(tid>>6);
  const long rowbase=(long)b*SEQ; const int q0=qb*QB;
  const bf16*Qw=Q+(rowbase+q0+wid*QBLK)*DM+h*D;
  const bf16*Kh=K+(rowbase+(long)kt0*KVBLK)*DM+h*D,*Vh=V+(rowbase+(long)kt0*KVBLK)*DM+h*D;
  const unsigned lds0=(unsigned)(uintptr_t)shm;
  float*wsf=(float*)(shm+LDS_WS)+wid*64;
  const bf16*ksrc=Kh+(long)lane*DM+wid*8;
  const bf16*vsrc=Vh+(long)(16*(wid&3)+(lane>>2))*DM+(wid>>2)*32+(lane&3)*8;
  const unsigned kdst=lds0+LDS_K+wid*1024, vdst=lds0+LDS_V+wid*1024;
  #define DMA_K(t,slot) glds16(ksrc+(long)(t)*KVBLK*DM,(unsigned)__builtin_amdgcn_readfirstlane(kdst+(slot)))
  #define DMA_V(t,slot) glds16(vsrc+(long)(t)*KVBLK*DM,(unsigned)__builtin_amdgcn_readfirstlane(vdst+(slot)))
  const int vb0=(int)(lds0+LDS_V)+((lane>>4)&1)*32+(lane&3)*8+(4*hi+((lane&15)>>2))*64;
  const char*Kbase=shm+LDS_K; bf16x8 kf[8];
  const lds_cptr shm3=(lds_cptr)shm; const lds_cptr kp0=shm3+LDS_K+hi*1024+r32*16; const lds_cptr vp0=shm3+LDS_V+((lane>>4)&1)*32+(lane&3)*8+(4*hi+((lane&15)>>2))*64;
  const int NT=(q0+QB)/KVBLK-kt0;
  DMA_K(0,0);DMA_V(0,0);DMA_K(1,SLOTB);
  bf16x8 qr[4];
  #pragma unroll
  for(int d0=0;d0<4;++d0)qr[d0]=*reinterpret_cast<const bf16x8*>(&Qw[(long)r32*DM+d0*16+hi*8]);
  float mhat=0.f,l_reg=0.f;f32x16 o[2];o[0]=f32x16{};o[1]=f32x16{};
  typedef float f32x4v __attribute__((ext_vector_type(4))); typedef __attribute__((address_space(3))) const f32x4v* lds_f4p;
  const lds_f4p bias4=(lds_f4p)((__attribute__((address_space(3))) const char*)shm+LDS_BIAS)+hi+(kt0)*16;
  #define CINIT(C0,C1,t) do{ const lds_f4p bp_=bias4+(t)*16; \
    _Pragma("unroll") for(int g_=0;g_<4;++g_){ const f32x4v x_=bp_[2*g_], y_=bp_[8+2*g_]; \
      C0[4*g_]=x_[0]-mhat; C0[4*g_+1]=x_[1]-mhat; C0[4*g_+2]=x_[2]-mhat; C0[4*g_+3]=x_[3]-mhat; \
      C1[4*g_]=y_[0]-mhat; C1[4*g_+1]=y_[1]-mhat; C1[4*g_+2]=y_[2]-mhat; C1[4*g_+3]=y_[3]-mhat; } }while(0)

  const int qrel=wid*QBLK+r32;
  #define CMASK(P0,P1,t) do{int jb_=(t)-(NT-4); if(jb_>=0)cmask(P0,P1,jb_,qrel,hi);}while(0)
  bool resc=false;
  #define START(P0,P1) do{ const float rm=rowmax(P0,P1); resc=false; \
    { const float dl=rm; mhat=fadd_s(mhat,dl); \
      _Pragma("unroll") for(int r=0;r<16;++r){P0[r]=fsub_s(P0[r],dl);P1[r]=fsub_s(P1[r],dl);} \
       } \
    _Pragma("unroll") for(int r=0;r<16;++r)P0[r]=__builtin_amdgcn_exp2f(P0[r]); }while(0)
  #define RESC() do{ if(resc){ asm volatile("s_waitcnt lgkmcnt(0)":::"memory"); \
      _Pragma("unroll") for(int d_=0;d_<2;++d_) _Pragma("unroll") for(int r=0;r<16;++r)o[d_][r]*=wsf[crow(r,hi)]; } }while(0)
  f32x16 pA0,pA1,pB0,pB1;
  int sl_prev=0,sl_cur=0,sl_next=SLOTB;
  #define ROT() do{sl_prev=sl_cur;sl_cur=sl_next;sl_next=(sl_next==(NSLOT-1)*SLOTB)?0:sl_next+SLOTB;}while(0)
  DMA_K(2,2*SLOTB);
  WAIT_BAR(3);
  CINIT(pA0,pA1,0); qkt(pA0,pA1,Kbase,qr,r32,hi);asm volatile("s_nop 15\n\ts_nop 7":"+v"(pA0),"+v"(pA1));CMASK(pA0,pA1,0);
  START(pA0,pA1);
  _Pragma("unroll") for(int r=0;r<16;++r)pA1[r]=__builtin_amdgcn_exp2f(pA1[r]);
  WAIT_BAR(0);
  DMA_K(3,0);DMA_V(1,SLOTB);
  ROT();
  kload8(kf,kp0+sl_cur);
  WAIT_BAR(2);
  s16x4 vlo[8],vhi[8]; u32x4 pw0,pw1,pw2,pw3;
  #define PKW(P,B) cvtpk_s(P[B],P[B+1])
  #define PAF(k) __builtin_bit_cast(bf16x8,pw##k)
  #define VFR(i) (bf16x8){vlo[i][0],vlo[i][1],vlo[i][2],vlo[i][3],vhi[i][0],vhi[i][1],vhi[i][2],vhi[i][3]}
  #define PIN(x) asm volatile("":"+v"(x))
  #define MX3(a,b,c) __builtin_fmaxf(__builtin_fmaxf((a),(b)),(c))
  #define GAPA(MF,A0,A1,A2,A3,W0,W1,PW) do{ MF; sacc+=A0; sacc+=A1; sacc+=A2; sacc+=A3; PIN(sacc); W0; W1; PIN(PW); SBAR(); }while(0)
  #define EX(v) __builtin_amdgcn_exp2f(v)
  #define GAPB(MF,X,B) do{ MF; X[B]=EX(X[B]); X[B+1]=EX(X[B+1]); X[B+2]=EX(X[B+2]); X[B+3]=EX(X[B+3]); PIN(X); SBAR(); }while(0)
  #define VRD(i) do{ vlo[i]=vtr(vp_+(((i)>>2)*4096+((i)&3)*1024)); vhi[i]=vtr(vp_+(((i)>>2)*4096+((i)&3)*1024+512)); }while(0)
  #define KRD(G,j) do{ if(G){ kload2(kf,kp0+sl_next,j); SBAR(); } }while(0)
  #define STEP(C0,C1,P0,P1,t,GK,GV,GL) do{ SBAR(); CINIT(C0,C1,t); SBAR(); \
    const lds_cptr vp_=vp0+sl_prev; \
    VRD(0); SBAR(); float sacc=(P0[0]+P0[1]); \
    GAPA(C0=__builtin_amdgcn_mfma_f32_32x32x16_bf16(kf[0],qr[0],C0,0,0,0), P0[2],P0[3],P0[4],P0[5],     pw0[0]=PKW(P0,0), pw0[1]=PKW(P0,2), pw0); \
    VRD(4); SBAR(); GAPA(C1=__builtin_amdgcn_mfma_f32_32x32x16_bf16(kf[1],qr[0],C1,0,0,0), P0[6],P0[7],P0[8],P0[9],     pw0[2]=PKW(P0,4), pw0[3]=PKW(P0,6), pw0); \
    VRD(1); SBAR(); GAPA(C0=__builtin_amdgcn_mfma_f32_32x32x16_bf16(kf[2],qr[1],C0,0,0,0),   P0[10],P0[11],P0[12],P0[13], pw1[0]=PKW(P0,8), pw1[1]=PKW(P0,10), pw1); \
    VRD(5); SBAR(); GAPA(C1=__builtin_amdgcn_mfma_f32_32x32x16_bf16(kf[3],qr[1],C1,0,0,0),   P0[14],P0[15],P1[0],P1[1],   pw1[2]=PKW(P0,12),pw1[3]=PKW(P0,14), pw1); \
    VRD(2); SBAR(); GAPA(C0=__builtin_amdgcn_mfma_f32_32x32x16_bf16(kf[4],qr[2],C0,0,0,0),   P1[2],P1[3],P1[4],P1[5],     pw2[0]=PKW(P1,0), pw2[1]=PKW(P1,2), pw2); \
    VRD(6); SBAR(); GAPA(C1=__builtin_amdgcn_mfma_f32_32x32x16_bf16(kf[5],qr[2],C1,0,0,0),   P1[6],P1[7],P1[8],P1[9],     pw2[2]=PKW(P1,4), pw2[3]=PKW(P1,6), pw2); \
    VRD(3); SBAR(); GAPA(C0=__builtin_amdgcn_mfma_f32_32x32x16_bf16(kf[6],qr[3],C0,0,0,0),   P1[10],P1[11],P1[12],P1[13], pw3[0]=PKW(P1,8), pw3[1]=PKW(P1,10), pw3); \
    VRD(7); SBAR(); GAPA(C1=__builtin_amdgcn_mfma_f32_32x32x16_bf16(kf[7],qr[3],C1,0,0,0),   P1[14],P1[15],0.f,0.f,       pw3[2]=PKW(P1,12),pw3[3]=PKW(P1,14), pw3); \
    l_reg+=sacc; \
    if(GK){DMA_K((t)+3,sl_cur);} if(GV){DMA_V((t)+1,sl_next);} \
    CMASK(C0,C1,t); \
    { float a=MX3(C0[0],C0[1],C1[0]),b=MX3(C0[2],C0[3],C1[1]); a=MX3(a,C1[2],C1[3]); \
      _Pragma("unroll") for(int r=4;r<16;r+=4){a=MX3(a,C0[r],C0[r+1]);b=MX3(b,C0[r+2],C0[r+3]);a=MX3(a,C1[r],C1[r+1]);b=MX3(b,C1[r+2],C1[r+3]);} \
      float rm=__builtin_fmaxf(a,b); { auto rr=__builtin_amdgcn_permlane32_swap(__float_as_uint(rm),__float_as_uint(rm),false,false); rm=__builtin_fmaxf(__uint_as_float(rr[0]),__uint_as_float(rr[1])); } \
      resc=false; \
      if(__builtin_expect(__any(rm>(float)THRL),0)){ const float dl=__builtin_fmaxf(rm,0.f); mhat+=dl; \
        _Pragma("unroll") for(int r=0;r<16;++r){C0[r]-=dl;C1[r]-=dl;} \
         \
        const float f=__builtin_amdgcn_exp2f(-dl); l_reg*=f; if(hi==0)wsf[r32]=f; resc=true; } } \
    SBAR(); \
    GAPB(o[0]=__builtin_amdgcn_mfma_f32_32x32x16_bf16(PAF(0),VFR(0),o[0],0,0,0), C0,0); \
    GAPB(o[1]=__builtin_amdgcn_mfma_f32_32x32x16_bf16(PAF(0),VFR(4),o[1],0,0,0), C0,4); \
    KRD(GL,0); GAPB(o[0]=__builtin_amdgcn_mfma_f32_32x32x16_bf16(PAF(1),VFR(1),o[0],0,0,0), C0,8); \
    KRD(GL,1); GAPB(o[1]=__builtin_amdgcn_mfma_f32_32x32x16_bf16(PAF(1),VFR(5),o[1],0,0,0), C0,12); \
    KRD(GL,2); GAPB(o[0]=__builtin_amdgcn_mfma_f32_32x32x16_bf16(PAF(2),VFR(2),o[0],0,0,0), C1,0); \
    KRD(GL,3); GAPB(o[1]=__builtin_amdgcn_mfma_f32_32x32x16_bf16(PAF(2),VFR(6),o[1],0,0,0), C1,4); \
    GAPB(o[0]=__builtin_amdgcn_mfma_f32_32x32x16_bf16(PAF(3),VFR(3),o[0],0,0,0), C1,8); \
    GAPB(o[1]=__builtin_amdgcn_mfma_f32_32x32x16_bf16(PAF(3),VFR(7),o[1],0,0,0), C1,12); \
    }while(0)
  int t=1;
  #undef CMASK
  #define CMASK(P0,P1,t) do{}while(0)
  for(;t+5<NT;t+=2){
    STEP(pB0,pB1,pA0,pA1,t,true,true,true);     WAIT_BAR(2); RESC(); ROT();
    STEP(pA0,pA1,pB0,pB1,t+1,true,true,true);   WAIT_BAR(2); RESC(); ROT();
  }
  #undef CMASK
  #define CMASK(P0,P1,t) do{int jb_=(t)-(NT-4); if(jb_>=0)cmask(P0,P1,jb_,qrel,hi);}while(0)
  #define ENDW(tt) do{ if((tt)+3<NT){WAIT_BAR(2);} else if((tt)+2<NT){WAIT_BAR(1);} else {WAIT_BAR(0);} }while(0)
  for(;t+1<NT;t+=2){
    STEP(pB0,pB1,pA0,pA1,t,(t+3<NT),(t+1<NT),(t+1<NT));       ENDW(t);   RESC(); ROT();
    STEP(pA0,pA1,pB0,pB1,t+1,(t+4<NT),(t+2<NT),(t+2<NT));     ENDW(t+1); RESC(); ROT();
  }
  STEP(pB0,pB1,pA0,pA1,NT-1,false,false,false); RESC();
  { float sacc=pB0[0]+pB0[1]; _Pragma("unroll") for(int r=2;r<16;++r)sacc+=pB0[r]; _Pragma("unroll") for(int r=0;r<16;++r)sacc+=pB1[r]; l_reg+=sacc;
    pw0=(u32x4){PKW(pB0,0),PKW(pB0,2),PKW(pB0,4),PKW(pB0,6)};pw1=(u32x4){PKW(pB0,8),PKW(pB0,10),PKW(pB0,12),PKW(pB0,14)};pw2=(u32x4){PKW(pB1,0),PKW(pB1,2),PKW(pB1,4),PKW(pB1,6)};pw3=(u32x4){PKW(pB1,8),PKW(pB1,10),PKW(pB1,12),PKW(pB1,14)};
    SBAR(); pv(o,vb0+sl_cur,PAF(0),PAF(1),PAF(2),PAF(3)); }
  #undef PKW
  #undef PAF
  #undef VFR
  #undef PIN
  #undef MX3
  #undef GAPA
  #undef GAPB
  #undef EX
  #undef VRD
  #undef KRD
  #undef STEP
  #undef ENDW
  {auto rr=__builtin_amdgcn_permlane32_swap(__float_as_uint(l_reg),__float_as_uint(l_reg),false,false);l_reg=__uint_as_float(rr[0])+__uint_as_float(rr[1]);}
  if(hi==0)wsf[32+r32]=l_reg;asm volatile("s_waitcnt lgkmcnt(0)":::"memory");
  float rli[16];
  #pragma unroll
  for(int r=0;r<16;++r)rli[r]=__builtin_amdgcn_rcpf(wsf[32+crow(r,hi)]);
  bf16*Ow=O+(rowbase+q0+wid*QBLK)*DM+h*D;
  { bf16*stg=(bf16*)(shm+LDS_OST)+wid*2048;
    #pragma unroll
    for(int r=0;r<16;++r){const int orow=crow(r,hi);
      #pragma unroll
      for(int d0=0;d0<2;++d0)stg[orow*64+d0*32+r32]=__float2bfloat16(o[d0][r]*rli[r]);}
    asm volatile("s_waitcnt lgkmcnt(0)":::"memory");
    #pragma unroll
    for(int i=0;i<4;++i){const int row=i*8+(lane>>3),ch=lane&7; const u32x4 v=*(const u32x4*)(stg+row*64+ch*8); ATTN_STORE16(Ow+(long)row*DM+ch*8,v);} }
  asm volatile("s_waitcnt lgkmcnt(0)\n\ts_barrier":::"memory");
  #undef DMA_K
  #undef DMA_V
  #undef CMASK
  #undef START
  #undef RESC
  #undef ROT
  #undef CINIT
}
constexpr int ATTN_LDS_BYTES=LDS_BYTES;
#undef SBAR
#undef WAIT_BAR
}
namespace cg = cooperative_groups;
#define GAS __attribute__((address_space(1)))
#define LAS __attribute__((address_space(3)))
typedef unsigned short bf16_t;
typedef unsigned v4u __attribute__((ext_vector_type(4)));
typedef unsigned v2u __attribute__((ext_vector_type(2)));
typedef float f32x4 __attribute__((ext_vector_type(4)));
typedef float f32x16 __attribute__((ext_vector_type(16)));
typedef short bf16x8 __attribute__((ext_vector_type(8)));
constexpr int NWAVES = 8, NTHR = 512;
constexpr int TP = 32768, TS = 512, T = TP + TS, D = 1024, DFF = 2816, DFF2 = 5632, NH = 16, HD = 64;
constexpr int SEQP = 8192, SEQS = 32, PAST = 4096, SKS = PAST + SEQS, NBP = 4, NBS = 16;
constexpr float EPS = 1e-6f, LOG2E = 1.4426950408889634f, C2 = 0.125f * 1.4426950408889634f;
constexpr size_t O_Y = 0, O_SGUV = 34078720, O_CONVP = 34603008, O_CONVS = 34693120, O_KP = 35053568, O_VP = 68608000, O_LFP = 102162432,
                 O_KS = 102686720, O_VS = 103211008, O_LFS = 103735296, O_END = 103743488;
constexpr size_t MiB = 1u << 20;
constexpr size_t WS_WF = 1 * MiB, WS_WSM = WS_WF + 65536, WS_WIN = 2 * MiB, WS_WOUT = 6 * MiB, WS_WUP0 = 8 * MiB, WS_WUP1 = 19 * MiB, WS_WDN0 = 30 * MiB, WS_WDN1 = 36 * MiB,
                 WS_WQKV = 42 * MiB, WS_WO = 48 * MiB, WS_SSQ0 = 50 * MiB, WS_SSQ1 = 53 * MiB, WS_SSQ2 = 56 * MiB, WS_SSQ3 = 59 * MiB, WS_VSTAT = 62 * MiB,
                 WS_CKP = 67 * MiB, WS_CKS = 69 * MiB, WS_R0 = 74 * MiB, WS_R1 = 139 * MiB, WS_R2 = 204 * MiB, WS_HB = 269 * MiB, WS_A = 334 * MiB, WS_G = 692 * MiB, WS_END = 871 * MiB;
constexpr int RING_BYTES = 131072, LDS_BYTES = 147456;

__device__ __forceinline__ unsigned f2bf(float f) { unsigned u = __builtin_bit_cast(unsigned, f); return (u + 0x7fffu + ((u >> 16) & 1u)) >> 16; }
__device__ __forceinline__ unsigned pk2(float lo, float hi) { return pg8::cvt_pk_bf16(lo, hi); }
__device__ __forceinline__ float bflo(unsigned w) { return __uint_as_float(w << 16); }
__device__ __forceinline__ float bfhi(unsigned w) { return __uint_as_float(w & 0xffff0000u); }
#define LDS_WAIT() asm volatile("s_waitcnt lgkmcnt(0)" ::: "memory")
__device__ __forceinline__ float wave_sum(float v) {
#pragma unroll
    for (int o = 1; o < 64; o <<= 1) v += __shfl_xor(v, o);
    return v;
}

struct Args { const float* in[27]; float* out; unsigned char* ws; int ph_lo, ph_hi; };
typedef const __attribute__((address_space(4))) Args* ArgP;

__device__ __forceinline__ void transpose_item(const float* W, int K, int N, bf16_t* WT, const float* g, int mode, int row_off, LAS float* scr, int item, int lane) {
    const int nblk = N / 32, kb = item / nblk, nb = item % nblk, k0 = 64 * kb, n0 = 32 * nb;
    float wv[32];
#pragma unroll
    for (int i = 0; i < 32; ++i) wv[i] = W[(size_t)(k0 + 2 * i + (lane >> 5)) * N + n0 + (lane & 31)];
#pragma unroll
    for (int i = 0; i < 32; ++i) { const int kk = 2 * i + (lane >> 5); float w = wv[i]; if (g) w *= g[k0 + kk]; scr[kk * 33 + (kk >> 5) + (lane & 31)] = w; }
    LDS_WAIT(); asm volatile("" ::: "memory");
    const int c = lane & 7;
#pragma unroll
    for (int j = 0; j < 4; ++j) { const int n = (lane >> 3) + 8 * j; const LAS float* s = scr + (8 * c) * 33 + (c >> 2) + n;
        v4u o; o.x = pk2(s[0 * 33], s[1 * 33]); o.y = pk2(s[2 * 33], s[3 * 33]); o.z = pk2(s[4 * 33], s[5 * 33]); o.w = pk2(s[6 * 33], s[7 * 33]);
        int nn = n0 + n; if (mode == 1) { const int l = nn & 255; nn = (nn & ~255) + 128 * ((l >> 5) & 1) + 32 * (l >> 6) + (l & 31); }
        if (mode == 3) { const int bj = nn >= DFF ? 1 : 0, q = nn - bj * DFF; nn = 256 * (q >> 7) + 128 * bj + (q & 127); }
        *(v4u*)(WT + (size_t)(row_off + nn) * K + k0 + 8 * c) = o; }
    LDS_WAIT(); asm volatile("" ::: "memory");
}
__device__ __forceinline__ void x_rows4(ArgP a, int m0, int lane) {
    bf16_t* XB = (bf16_t*)(a->ws + WS_R0); float* ssq0 = (float*)(a->ws + WS_SSQ0);
    const float* xr = m0 < TP ? a->in[0] + (size_t)m0 * D : a->in[1] + (size_t)(m0 - TP) * D;
    f32x4 v[4][4];
#pragma unroll
    for (int r = 0; r < 4; ++r)
#pragma unroll
        for (int j = 0; j < 4; ++j) v[r][j] = __builtin_nontemporal_load((const f32x4*)(xr + (size_t)r * D) + lane + 64 * j);
#pragma unroll
    for (int r = 0; r < 4; ++r) { float s = 0.f;
#pragma unroll
        for (int j = 0; j < 4; ++j) { s += (v[r][j][0] * v[r][j][0] + v[r][j][1] * v[r][j][1]) + (v[r][j][2] * v[r][j][2] + v[r][j][3] * v[r][j][3]);
            v2u o; o.x = pk2(v[r][j][0], v[r][j][1]); o.y = pk2(v[r][j][2], v[r][j][3]); ((v2u*)(XB + (size_t)(m0 + r) * D))[lane + 64 * j] = o; }
        s = wave_sum(s);
        if (lane < 16) ssq0[(size_t)(m0 + r) * 16 + lane] = lane == 0 ? s : 0.f; }
}
__device__ __forceinline__ bool p0_prologue(ArgP a, LAS unsigned char* lds, int G, int bx, int tid, int wave, int lane, unsigned* ctr) {
    unsigned char* ws = a->ws;
    LAS float* scr = (LAS float*)(lds + wave * 16384);
    constexpr int I_IN = 16 * 64, I_OUT = 16 * 32, I_UP = 16 * 176, I_DN = 44 * 32, I_SQ = 16 * 32;
    constexpr int NITEMS = I_OUT + 2 * I_UP + 2 * I_DN + 4 * I_SQ;
    const bool split = G >= 32;
    for (int it = bx * NWAVES + wave; it < I_IN + TS / 4; it += G * NWAVES) {
        if (it < I_IN) transpose_item(a->in[8], D, 2 * D, (bf16_t*)(ws + WS_WIN), a->in[6], 0, 0, scr, it, lane);
        else x_rows4(a, TP + 4 * (it - I_IN), lane);
    }
    if (split) { pg8::part_arrive(ctr, tid); if (bx < 16) { pg8::part_wait(ctr, (unsigned)G, tid); return true; } }
    const int skip = split ? 16 : 0, gw = (bx - skip) * NWAVES + wave, NGW = (G - skip) * NWAVES;
    for (int it = gw; it < NITEMS; it += NGW) {
        int r = it;
        if (r < I_OUT) { transpose_item(a->in[13], D, D, (bf16_t*)(ws + WS_WOUT), nullptr, 0, 0, scr, r, lane); continue; } r -= I_OUT;
        if (r < I_UP) { transpose_item(a->in[14], D, DFF2, (bf16_t*)(ws + WS_WUP0), a->in[7], 3, 0, scr, r, lane); continue; } r -= I_UP;
        if (r < I_UP) { transpose_item(a->in[14] + (size_t)D * DFF2, D, DFF2, (bf16_t*)(ws + WS_WUP1), a->in[7] + D, 3, 0, scr, r, lane); continue; } r -= I_UP;
        if (r < I_DN) { transpose_item(a->in[17], DFF, D, (bf16_t*)(ws + WS_WDN0), nullptr, 0, 0, scr, r, lane); continue; } r -= I_DN;
        if (r < I_DN) { transpose_item(a->in[17] + (size_t)DFF * D, DFF, D, (bf16_t*)(ws + WS_WDN1), nullptr, 0, 0, scr, r, lane); continue; } r -= I_DN;
        if (r < I_SQ) { transpose_item(a->in[24], D, D, (bf16_t*)(ws + WS_WQKV), a->in[6] + D, 1, 0, scr, r, lane); continue; } r -= I_SQ;
        if (r < I_SQ) { transpose_item(a->in[19], D, D, (bf16_t*)(ws + WS_WQKV), a->in[18], 1, D, scr, r, lane); continue; } r -= I_SQ;
        if (r < I_SQ) { transpose_item(a->in[20], D, D, (bf16_t*)(ws + WS_WQKV), a->in[18], 1, 2 * D, scr, r, lane); continue; } r -= I_SQ;
        transpose_item(a->in[26], D, D, (bf16_t*)(ws + WS_WO), nullptr, 0, 0, scr, r, lane);
    }
    { const int gt = gw * 64 + lane, NGT = NGW * 64; bf16_t* wf = (bf16_t*)(ws + WS_WF); bf16_t* wsm = (bf16_t*)(ws + WS_WSM);
        for (int e = gt; e < 16 * D; e += NGT) { const int n = e >> 10, k = e & 1023; wf[e] = (bf16_t)f2bf(a->in[22][k * 16 + n] * a->in[18][k]); }
        for (int e = gt; e < 4 * 128 * 128; e += NGT) { const int i = (e >> 7) & 127, j = e & 127; wsm[e] = (bf16_t)f2bf(((j >> 6) <= (i >> 6)) ? a->in[11][e] : 0.f); } }
    for (int m0 = gw * 4; m0 < TP; m0 += NGW * 4) x_rows4(a, m0, lane);
    return false;
}

__device__ __forceinline__ void sgu_unit(ArgP a, LAS unsigned char* lds, int un, int tid, int wave, int lane) {
    unsigned char* ws = a->ws;
    const bf16_t* U = (const bf16_t*)(ws + WS_R1); const bf16_t* VP = (const bf16_t*)(ws + WS_R2); bf16_t* SG = (bf16_t*)(ws + WS_G);
    const float* vstat = (const float*)(ws + WS_VSTAT); const bf16_t* wsm = (const bf16_t*)(ws + WS_WSM);
    const float* lng = a->in[9]; const float* lnb = a->in[10]; const float* bs = a->in[12];
    constexpr int VPITCH = 136;
    LAS bf16_t* VT = (LAS bf16_t*)lds; LAS float* st = (LAS float*)(lds + 256 * VPITCH * 2);
    {
        const int nb = un >> 2, g = un & 3; const bool smp = nb >= 256;
        const int row0 = smp ? TP + (nb - 256) * 32 : nb * 128, nrows = smp ? 32 : 128;
        if (tid < nrows) { const float* p = vstat + (size_t)(row0 + tid) * 32; float s = 0.f, s2 = 0.f;
#pragma unroll
            for (int k = 0; k < 16; ++k) { s += p[2 * k]; s2 += p[2 * k + 1]; }
            const float mean = s * (1.f / 1024.f), var = fmaxf(s2 * (1.f / 1024.f) - mean * mean, 0.f);
            st[2 * tid] = mean; st[2 * tid + 1] = __builtin_amdgcn_rsqf(var + EPS); }
        __syncthreads();
        const int fr0_ = lane & 15, fq0_ = lane >> 4, nit0_ = nrows >> 4; const bf16_t* wg0_ = wsm + (size_t)g * 128 * 128; bf16x8 wf0[8];
#pragma unroll
        for (int it = 0; it < 8; ++it) if (it < nit0_) wf0[it] = *(const bf16x8*)(wg0_ + (it * 16 + fr0_) * 128 + fq0_ * 8);
        const int jsh = smp ? 5 : 7;
        for (int it = tid; it < nrows * 32; it += NTHR) {
            const int j = it & (nrows - 1), cc = (it >> jsh) * 8, c = g * 256 + cc; const float mean = st[2 * j], rstd = st[2 * j + 1];
            const v4u raw = *(const v4u*)(VP + (size_t)(row0 + j) * D + c);
            const f32x4 g0 = *(const f32x4*)(lng + c), g1 = *(const f32x4*)(lng + c + 4), b0 = *(const f32x4*)(lnb + c), b1 = *(const f32x4*)(lnb + c + 4);
            float v[8];
            v[0] = (bflo(raw.x) - mean) * rstd * g0[0] + b0[0]; v[1] = (bfhi(raw.x) - mean) * rstd * g0[1] + b0[1];
            v[2] = (bflo(raw.y) - mean) * rstd * g0[2] + b0[2]; v[3] = (bfhi(raw.y) - mean) * rstd * g0[3] + b0[3];
            v[4] = (bflo(raw.z) - mean) * rstd * g1[0] + b1[0]; v[5] = (bfhi(raw.z) - mean) * rstd * g1[1] + b1[1];
            v[6] = (bflo(raw.w) - mean) * rstd * g1[2] + b1[2]; v[7] = (bfhi(raw.w) - mean) * rstd * g1[3] + b1[3];
            if (smp) { float* o = a->out + O_SGUV + (size_t)(row0 - TP + j) * D + c; *(f32x4*)o = (f32x4){v[0], v[1], v[2], v[3]}; *(f32x4*)(o + 4) = (f32x4){v[4], v[5], v[6], v[7]}; }
#pragma unroll
            for (int e = 0; e < 8; ++e) VT[(cc + e) * VPITCH + j] = (bf16_t)f2bf(v[e]);
        }
        __syncthreads();
        const int fr = lane & 15, fq = lane >> 4, nit = nrows >> 4, nks = nrows >> 5;
        f32x4 acc[8][2];
#pragma unroll
        for (int i = 0; i < 8; ++i) { acc[i][0] = (f32x4){0.f, 0.f, 0.f, 0.f}; acc[i][1] = (f32x4){0.f, 0.f, 0.f, 0.f}; }
        const bf16_t* wg = wsm + (size_t)g * 128 * 128;
#pragma unroll 2
        for (int ks = 0; ks < nks; ++ks) {
            bf16x8 wfr[8];
#pragma unroll
            for (int it = 0; it < 8; ++it) if (it < nit) wfr[it] = ks == 0 ? wf0[it] : *(const bf16x8*)(wg + (it * 16 + fr) * 128 + ks * 32 + fq * 8);
            const bf16x8 va = *(const LAS bf16x8*)(VT + (wave * 32 + fr) * VPITCH + ks * 32 + fq * 8);
            const bf16x8 vb = *(const LAS bf16x8*)(VT + (wave * 32 + 16 + fr) * VPITCH + ks * 32 + fq * 8);
#pragma unroll
            for (int it = 0; it < 8; ++it) if (it < nit) {
                const bf16x8 wf = wfr[it];
                acc[it][0] = __builtin_amdgcn_mfma_f32_16x16x32_bf16(va, wf, acc[it][0], 0, 0, 0);
                acc[it][1] = __builtin_amdgcn_mfma_f32_16x16x32_bf16(vb, wf, acc[it][1], 0, 0, 0);
            }
        }
#pragma unroll
        for (int it = 0; it < 8; ++it) if (it < nit) {
            const int i = it * 16 + fr; const float bsv = bs[g * 128 + i];
#pragma unroll
            for (int ct = 0; ct < 2; ++ct) { const size_t off = (size_t)(row0 + i) * D + g * 256 + wave * 32 + ct * 16 + 4 * fq;
                const v2u uu = *(const v2u*)(U + off); const f32x4 m = acc[it][ct] + bsv;
                v2u o; o.x = pk2(bflo(uu.x) * m[0], bfhi(uu.x) * m[1]); o.y = pk2(bflo(uu.y) * m[2], bfhi(uu.y) * m[3]); *(v2u*)(SG + off) = o; }
        }
        __syncthreads();
    }
}

__device__ __forceinline__ void load8(const bf16_t* p, float (&o)[8]) { const v4u r = *(const v4u*)p; o[0] = bflo(r.x); o[1] = bfhi(r.x); o[2] = bflo(r.y); o[3] = bfhi(r.y); o[4] = bflo(r.z); o[5] = bfhi(r.z); o[6] = bflo(r.w); o[7] = bfhi(r.w); }
__device__ __forceinline__ void load8f(const float* p, float (&o)[8]) { const f32x4 a = *(const f32x4*)p, b = *(const f32x4*)(p + 4); o[0] = a[0]; o[1] = a[1]; o[2] = a[2]; o[3] = a[3]; o[4] = b[0]; o[5] = b[1]; o[6] = b[2]; o[7] = b[3]; }
__device__ __forceinline__ void ctr_arrive(unsigned* ctr, int tid) {
    asm volatile("s_waitcnt vmcnt(0)" ::: "memory"); __syncthreads();
    if (__builtin_amdgcn_readfirstlane(tid >> 6) == 0) { __builtin_amdgcn_fence(__ATOMIC_RELEASE, "agent"); asm volatile("s_waitcnt vmcnt(0)" ::: "memory");
        __hip_atomic_fetch_add(ctr, (tid & 63) == 0 ? 1u : 0u, __ATOMIC_RELAXED, __HIP_MEMORY_SCOPE_AGENT); }
}
__device__ __forceinline__ void ctr_wait(unsigned* ctr, unsigned need, int tid) {
    if (__builtin_amdgcn_readfirstlane(tid >> 6) == 0) {
        while ((unsigned)__builtin_amdgcn_readfirstlane((int)__hip_atomic_load(ctr, __ATOMIC_RELAXED, __HIP_MEMORY_SCOPE_AGENT)) < need) __builtin_amdgcn_s_sleep(2);
        __builtin_amdgcn_fence(__ATOMIC_ACQUIRE, "agent"); asm volatile("s_waitcnt vmcnt(0)" ::: "memory"); }
    __syncthreads();
}
__device__ __forceinline__ void conv_item(const bf16_t* A, bf16_t* Gb, const float* cw, const float* cb, const float* cst, int rb, int jc) {
    const int r0 = rb * 16, col = jc * 8;
    float w0g[8], w1g[8], w2g[8], bg[8], w0v[8], w1v[8], w2v[8], bv[8];
    load8f(cw + col, w0g); load8f(cw + DFF2 + col, w1g); load8f(cw + 2 * DFF2 + col, w2g); load8f(cb + col, bg);
    load8f(cw + DFF + col, w0v); load8f(cw + DFF2 + DFF + col, w1v); load8f(cw + 2 * DFF2 + DFF + col, w2v); load8f(cb + DFF + col, bv);
    float g2[8], g1[8], v2[8], v1[8];
    const int t0 = r0 < TP ? (r0 & (SEQP - 1)) : ((r0 - TP) & (SEQS - 1));
    if (t0 == 0) {
        if (r0 < TP) {
#pragma unroll
            for (int e = 0; e < 8; ++e) { g2[e] = 0.f; g1[e] = 0.f; v2[e] = 0.f; v1[e] = 0.f; }
        } else { const float* sp = cst + (size_t)((r0 - TP) >> 5) * 2 * DFF2 + col; load8f(sp, g2); load8f(sp + DFF2, g1); load8f(sp + DFF, v2); load8f(sp + DFF2 + DFF, v1); }
    } else { const bf16_t* ap = A + (size_t)(r0 - 2) * DFF2 + col; load8(ap, g2); load8(ap + DFF2, g1); load8(ap + DFF, v2); load8(ap + DFF2 + DFF, v1); }
#pragma unroll 2
    for (int i = 0; i < 16; ++i) {
        const bf16_t* ap = A + (size_t)(r0 + i) * DFF2 + col; float g0[8], v0[8]; load8(ap, g0); load8(ap + DFF, v0);
        float o[8];
#pragma unroll
        for (int e = 0; e < 8; ++e) { const float cgv = g0[e] * w2g[e] + g1[e] * w1g[e] + g2[e] * w0g[e] + bg[e], cvv = v0[e] * w2v[e] + v1[e] * w1v[e] + v2[e] * w0v[e] + bv[e];
            o[e] = cgv * __builtin_amdgcn_rcpf(1.0f + __builtin_amdgcn_exp2f(-LOG2E * cgv)) * cvv; g2[e] = g1[e]; g1[e] = g0[e]; v2[e] = v1[e]; v1[e] = v0[e]; }
        v4u w; w.x = pk2(o[0], o[1]); w.y = pk2(o[2], o[3]); w.z = pk2(o[4], o[5]); w.w = pk2(o[6], o[7]);
        *(v4u*)(Gb + (size_t)(r0 + i) * DFF + col) = w;
    }
}
__device__ __forceinline__ void conv_fix_item(const float* stash, bf16_t* Gb, const float* cw, const float* cb, int b, int jc) {
    const int col = jc * 8;
    float w0g[8], w1g[8], w2g[8], bg[8], w0v[8], w1v[8], w2v[8], bv[8];
    load8f(cw + col, w0g); load8f(cw + DFF2 + col, w1g); load8f(cw + 2 * DFF2 + col, w2g); load8f(cb + col, bg);
    load8f(cw + DFF + col, w0v); load8f(cw + DFF2 + DFF + col, w1v); load8f(cw + 2 * DFF2 + DFF + col, w2v); load8f(cb + DFF + col, bv);
    float g2[8], g1[8], v2[8], v1[8], c0g[8], c0v[8], c1g[8], c1v[8];
    const float* sb = stash + (size_t)b * 8 * DFF + col;
    load8f(sb, c0g); load8f(sb + DFF, c0v); load8f(sb + 2 * DFF, c1g); load8f(sb + 3 * DFF, c1v);
    if ((b & 127) == 0) {
#pragma unroll
        for (int e = 0; e < 8; ++e) { g2[e] = 0.f; g1[e] = 0.f; v2[e] = 0.f; v1[e] = 0.f; }
    } else { const float* sp = sb - (size_t)8 * DFF; load8f(sp + 4 * DFF, g2); load8f(sp + 5 * DFF, v2); load8f(sp + 6 * DFF, g1); load8f(sp + 7 * DFF, v1); }
    float o0[8], o1[8];
#pragma unroll
    for (int e = 0; e < 8; ++e) {
        const float a0 = c0g[e] * w2g[e] + g1[e] * w1g[e] + g2[e] * w0g[e] + bg[e], b0 = c0v[e] * w2v[e] + v1[e] * w1v[e] + v2[e] * w0v[e] + bv[e];
        const float a1 = c1g[e] * w2g[e] + c0g[e] * w1g[e] + g1[e] * w0g[e] + bg[e], b1 = c1v[e] * w2v[e] + c0v[e] * w1v[e] + v1[e] * w0v[e] + bv[e];
        o0[e] = a0 * __builtin_amdgcn_rcpf(1.0f + __builtin_amdgcn_exp2f(-LOG2E * a0)) * b0; o1[e] = a1 * __builtin_amdgcn_rcpf(1.0f + __builtin_amdgcn_exp2f(-LOG2E * a1)) * b1; }
    v4u w; w.x = pk2(o0[0], o0[1]); w.y = pk2(o0[2], o0[3]); w.z = pk2(o0[4], o0[5]); w.w = pk2(o0[6], o0[7]); *(v4u*)(Gb + (size_t)(b * 64) * DFF + col) = w;
    w.x = pk2(o1[0], o1[1]); w.y = pk2(o1[2], o1[3]); w.z = pk2(o1[4], o1[5]); w.w = pk2(o1[6], o1[7]); *(v4u*)(Gb + (size_t)(b * 64 + 1) * DFF + col) = w;
}
__device__ __forceinline__ bool conv_phase(ArgP a, int layer, int G, int tid, int bx, unsigned* ctr) {
    const bf16_t* A = (const bf16_t*)(a->ws + WS_A); bf16_t* Gb = (bf16_t*)(a->ws + WS_G);
    const float* cw = a->in[15] + (size_t)layer * 3 * DFF2; const float* cb = a->in[16] + (size_t)layer * DFF2; const float* cst = a->in[5] + (size_t)layer * NBS * 2 * DFF2;
    constexpr int NJC = DFF / 8; const bool split = G >= 64;
    if (split) {
        for (int it = bx * NTHR + tid; it < (TS / 16) * NJC; it += G * NTHR) { const int rbl = it / NJC; conv_item(A, Gb, cw, cb, cst, TP / 16 + rbl, it - rbl * NJC); }
        ctr_arrive(ctr, tid);
        if (bx < 32) { ctr_wait(ctr, (unsigned)G, tid); return true; }
    }
    const int skip = split ? 32 : 0, gt = (bx - skip) * NTHR + tid, NGT = (G - skip) * NTHR;
    if (!split) for (int it = gt; it < (TS / 16) * NJC; it += NGT) { const int rbl = it / NJC; conv_item(A, Gb, cw, cb, cst, TP / 16 + rbl, it - rbl * NJC); }
    const float* stash = (const float*)(a->ws + WS_A);
    for (int it = gt; it < (TP / 64) * NJC; it += NGT) { const int b = it / NJC; conv_fix_item(stash, Gb, cw, cb, b, it - b * NJC); }
    return false;
}

__device__ __forceinline__ void logf_units(ArgP a, int gw, int NGW, int lane) {
    const bf16_t* HB = (const bf16_t*)(a->ws + WS_HB); const bf16_t* wf = (const bf16_t*)(a->ws + WS_WF); const float* ssq = (const float*)(a->ws + WS_SSQ2);
    const int fr = lane & 15, fq = lane >> 4; const float bf = a->in[23][fr];
    for (int grp = gw; grp < T / 16; grp += NGW) {
        const int row0 = grp * 16; f32x4 acc = (f32x4){0.f, 0.f, 0.f, 0.f};
        const bf16_t* ap = HB + (size_t)(row0 + fr) * D + fq * 8; const bf16_t* bp = wf + (size_t)fr * D + fq * 8;
#pragma unroll 8
        for (int ks = 0; ks < 32; ++ks) acc = __builtin_amdgcn_mfma_f32_16x16x32_bf16(*(const bf16x8*)(ap + ks * 32), *(const bf16x8*)(bp + ks * 32), acc, 0, 0, 0);
#pragma unroll
        for (int r = 0; r < 4; ++r) { const int row = row0 + 4 * fq + r; const f32x4* sp = (const f32x4*)(ssq + (size_t)row * 16);
            const f32x4 s0 = sp[0], s1 = sp[1], s2 = sp[2], s3 = sp[3];
            const float ss = ((s0[0] + s0[1]) + (s0[2] + s0[3])) + ((s1[0] + s1[1]) + (s1[2] + s1[3])) + ((s2[0] + s2[1]) + (s2[2] + s2[3])) + ((s3[0] + s3[1]) + (s3[2] + s3[3]));
            const float x = acc[r] * __builtin_amdgcn_rsqf(ss * (1.f / 1024.f) + EPS) + bf;
            const float lf = fminf(x, 0.f) - log1pf(__expf(-fabsf(x)));
            a->out[(row < TP ? O_LFP + (size_t)row * 16 : O_LFS + (size_t)(row - TP) * 16) + fr] = lf; }
    }
}

__device__ __forceinline__ void scan_unit(const float* src0, int n0, int stride0, const float* src1, int n1, int stride1, float* dst, LAS float* sh, int tid, int wave, int lane, int* ktab = nullptr, float ref_off = 0.f) {
    const int n = n0 + n1, base = tid * 16; float v[16]; float s = 0.f;
    const float* sp = nullptr; int st = 0;
    if (base < n0) { sp = src0 + (size_t)base * stride0; st = stride0; } else if (base < n) { sp = src1 + (size_t)(base - n0) * stride1; st = stride1; }
    if (sp) {
#pragma unroll
        for (int e = 0; e < 16; ++e) v[e] = sp[(size_t)e * st];
    } else {
#pragma unroll
        for (int e = 0; e < 16; ++e) v[e] = 0.f;
    }
#pragma unroll
    for (int e = 0; e < 16; ++e) { s += v[e]; v[e] = s; }
    float sc = s;
#pragma unroll
    for (int o = 1; o < 64; o <<= 1) { const float t = __shfl_up(sc, o); if (lane >= o) sc += t; }
    if (lane == 63) sh[wave] = sc;
    __syncthreads();
    float pre = 0.f;
#pragma unroll
    for (int w = 0; w < NWAVES; ++w) if (w < wave) pre += sh[w];
    const float excl = pre + sc - s;
    if (ktab) {
        LAS float* tl = sh + 16;
        if ((tid & 3) == 3) tl[tid >> 2] = -(excl + v[15]) * LOG2E;
        if ((tid & 15) == 0) tl[128 + (tid >> 4)] = -(excl + v[0]) * LOG2E;
        __syncthreads();
        if (tid < 32) { const float ref = tl[128 + tid] - ref_off; int lo_ = 0, hi_ = 4 * tid;
            while (lo_ < hi_) { const int mid = (lo_ + hi_ + 1) >> 1; if (tl[mid - 1] < ref) lo_ = mid; else hi_ = mid - 1; }
            ktab[tid] = lo_ & ~1; }
    }
    if (base < n) {
#pragma unroll
        for (int e = 0; e < 16; e += 4) *(f32x4*)(dst + base + e) = (f32x4){-(excl + v[e]) * LOG2E, -(excl + v[e + 1]) * LOG2E, -(excl + v[e + 2]) * LOG2E, -(excl + v[e + 3]) * LOG2E};
    }
    __syncthreads();
}

__device__ __forceinline__ bf16x8 pack8(const f32x4 a, const f32x4 b) { v4u w; w.x = pk2(a[0], a[1]); w.y = pk2(a[2], a[3]); w.z = pk2(b[0], b[1]); w.w = pk2(b[2], b[3]); return __builtin_bit_cast(bf16x8, w); }
__device__ __forceinline__ void attn_sample_unit(ArgP a, int s, int h, LAS unsigned char* lds, int tid, int wave, int lane) {
    const bf16_t* Q = (const bf16_t*)(a->ws + WS_R0); const bf16_t* Kn = (const bf16_t*)(a->ws + WS_R1); const bf16_t* Vn = (const bf16_t*)(a->ws + WS_R2); bf16_t* O = (bf16_t*)(a->ws + WS_R0);
    const float* kb = (const float*)(a->ws + WS_CKS) + (size_t)(s * NH + h) * SKS;
    const float* ck = a->in[2] + ((size_t)s * PAST * NH + h) * HD; const float* cv = a->in[3] + ((size_t)s * PAST * NH + h) * HD;
    const int r32 = lane & 31, hi = lane >> 5, row0 = TP + s * SEQS;
    bf16x8 qr[4];
#pragma unroll
    for (int d0 = 0; d0 < 4; ++d0) qr[d0] = *(const bf16x8*)(Q + (size_t)(row0 + r32) * D + h * HD + d0 * 16 + hi * 8);
    float m = -1e30f, l = 0.f; f32x16 o0 = {}, o1 = {};
#define SMP_TILE(kf, vf, kbp, MASK) do { f32x16 p; \
        _Pragma("unroll") for (int g_ = 0; g_ < 4; ++g_) { const f32x4 bb = *(const f32x4*)((kbp) + 8 * g_ + 4 * hi); p[4 * g_] = bb[0]; p[4 * g_ + 1] = bb[1]; p[4 * g_ + 2] = bb[2]; p[4 * g_ + 3] = bb[3]; } \
        _Pragma("unroll") for (int d0 = 0; d0 < 4; ++d0) p = __builtin_amdgcn_mfma_f32_32x32x16_bf16(kf[d0], qr[d0], p, 0, 0, 0); \
        if (MASK) { _Pragma("unroll") for (int r = 0; r < 16; ++r) { const int key = (r & 3) + 8 * (r >> 2) + 4 * hi; if (key > r32) p[r] = -1e30f; } } \
        float mx = p[0]; _Pragma("unroll") for (int r = 1; r < 16; ++r) mx = fmaxf(mx, p[r]); \
        mx = fmaxf(mx, __shfl_xor(mx, 32)); const float mn = fmaxf(m, mx), f = __builtin_amdgcn_exp2f(m - mn); m = mn; float ls = 0.f; \
        _Pragma("unroll") for (int r = 0; r < 16; ++r) { p[r] = __builtin_amdgcn_exp2f(p[r] - mn); ls += p[r]; } \
        l = l * f + ls; o0 = o0 * f; o1 = o1 * f; \
        v4u w0, w1; w0.x = pk2(p[0], p[1]); w0.y = pk2(p[2], p[3]); w0.z = pk2(p[4], p[5]); w0.w = pk2(p[6], p[7]); w1.x = pk2(p[8], p[9]); w1.y = pk2(p[10], p[11]); w1.z = pk2(p[12], p[13]); w1.w = pk2(p[14], p[15]); \
        const bf16x8 pw0 = __builtin_bit_cast(bf16x8, w0), pw1 = __builtin_bit_cast(bf16x8, w1); \
        o0 = __builtin_amdgcn_mfma_f32_32x32x16_bf16(vf[0][0], pw0, o0, 0, 0, 0); o0 = __builtin_amdgcn_mfma_f32_32x32x16_bf16(vf[0][1], pw1, o0, 0, 0, 0); \
        o1 = __builtin_amdgcn_mfma_f32_32x32x16_bf16(vf[1][0], pw0, o1, 0, 0, 0); o1 = __builtin_amdgcn_mfma_f32_32x32x16_bf16(vf[1][1], pw1, o1, 0, 0, 0); } while (0)
    f32x4 kraw[8]; float vraw[32];
#define SMP_LOAD(tt_) do { const int key0_ = (wave * 16 + (tt_)) * 32; const float* kp_ = ck + (size_t)(key0_ + r32) * (NH * HD) + hi * 8; \
        _Pragma("unroll") for (int d0 = 0; d0 < 4; ++d0) { kraw[2 * d0] = *(const f32x4*)(kp_ + d0 * 16); kraw[2 * d0 + 1] = *(const f32x4*)(kp_ + d0 * 16 + 4); } \
        _Pragma("unroll") for (int d0b = 0; d0b < 2; ++d0b) _Pragma("unroll") for (int ks = 0; ks < 2; ++ks) _Pragma("unroll") for (int e = 0; e < 8; ++e) \
            vraw[(d0b * 2 + ks) * 8 + e] = cv[(size_t)(key0_ + 16 * ks + 4 * hi + (e & 3) + 8 * (e >> 2)) * (NH * HD) + d0b * 32 + r32]; } while (0)
    SMP_LOAD(0);
    for (int tt = 0; tt < 16; ++tt) {
        const int key0 = (wave * 16 + tt) * 32;
        bf16x8 kf[4], vf[2][2];
#pragma unroll
        for (int d0 = 0; d0 < 4; ++d0) kf[d0] = pack8(kraw[2 * d0], kraw[2 * d0 + 1]);
#pragma unroll
        for (int d0b = 0; d0b < 2; ++d0b)
#pragma unroll
            for (int ks = 0; ks < 2; ++ks) { const float* x = vraw + (d0b * 2 + ks) * 8; vf[d0b][ks] = pack8((f32x4){x[0], x[1], x[2], x[3]}, (f32x4){x[4], x[5], x[6], x[7]}); }
        if (tt + 1 < 16) SMP_LOAD(tt + 1);
        SMP_TILE(kf, vf, kb + key0, false);
    }
#undef SMP_LOAD
    if (wave == 0) {
        bf16x8 kf[4], vf[2][2];
#pragma unroll
        for (int d0 = 0; d0 < 4; ++d0) kf[d0] = *(const bf16x8*)(Kn + (size_t)(row0 + r32) * D + h * HD + d0 * 16 + hi * 8);
#pragma unroll
        for (int d0b = 0; d0b < 2; ++d0b)
#pragma unroll
            for (int ks = 0; ks < 2; ++ks) { unsigned x[8];
#pragma unroll
                for (int e = 0; e < 8; ++e) x[e] = Vn[(size_t)(row0 + 16 * ks + 4 * hi + (e & 3) + 8 * (e >> 2)) * D + h * HD + d0b * 32 + r32];
                v4u w; w.x = x[0] | (x[1] << 16); w.y = x[2] | (x[3] << 16); w.z = x[4] | (x[5] << 16); w.w = x[6] | (x[7] << 16); vf[d0b][ks] = __builtin_bit_cast(bf16x8, w); }
        SMP_TILE(kf, vf, kb + PAST, true);
    }
#undef SMP_TILE
    l += __shfl_xor(l, 32);
    LAS float* po = (LAS float*)lds + wave * 2048; LAS float* pm = (LAS float*)(lds + 65536) + wave * 64;
#pragma unroll
    for (int r = 0; r < 16; ++r) { const int d = (r & 3) + 8 * (r >> 2) + 4 * hi; po[d * 32 + r32] = o0[r]; po[(d + 32) * 32 + r32] = o1[r]; }
    if (hi == 0) { pm[r32] = m; pm[32 + r32] = l; }
    __syncthreads();
    { const int q = tid & 31, d0 = (tid >> 5) * 4; float M = -1e30f;
#pragma unroll
        for (int w = 0; w < NWAVES; ++w) M = fmaxf(M, ((LAS float*)(lds + 65536))[w * 64 + q]);
        float L = 0.f, oo[4] = {0.f, 0.f, 0.f, 0.f};
#pragma unroll
        for (int w = 0; w < NWAVES; ++w) { const float f = __builtin_amdgcn_exp2f(((LAS float*)(lds + 65536))[w * 64 + q] - M); L += f * ((LAS float*)(lds + 65536))[w * 64 + 32 + q];
#pragma unroll
            for (int e = 0; e < 4; ++e) oo[e] += f * ((LAS float*)lds)[w * 2048 + (d0 + e) * 32 + q]; }
        const float rl = 1.0f / L; v2u o; o.x = pk2(oo[0] * rl, oo[1] * rl); o.y = pk2(oo[2] * rl, oo[3] * rl);
        *(v2u*)(O + (size_t)(row0 + q) * D + h * HD + d0) = o; }
    __syncthreads();
}

constexpr int NPHASE = 14;
__global__ void __launch_bounds__(NTHR, 2) yoco_fwd(Args args) {
    extern __shared__ __attribute__((aligned(16))) unsigned char lds_raw[];
    cg::grid_group grid = cg::this_grid();
    LAS unsigned char* lds = (LAS unsigned char*)lds_raw;
    const int G = gridDim.x, bx = blockIdx.x, vcu = (G % 8 == 0) ? (bx % 8) * (G / 8) + bx / 8 : bx;
    const int NGW = G * NWAVES;
    const int wv0 = __builtin_amdgcn_readfirstlane((int)threadIdx.x >> 6);
    const int vblk = bx;
#define MYTID() ((wv0 << 6) | (int)__builtin_amdgcn_mbcnt_hi(~0u, __builtin_amdgcn_mbcnt_lo(~0u, 0u)))
#define TIDS() const int tid = ({ int t_ = MYTID(); asm volatile("" : "+v"(t_)); t_; }), lane = tid & 63, wave = __builtin_amdgcn_readfirstlane(tid >> 6), gw = vcu * NWAVES + wave; (void)lane; (void)gw
    ArgP argp = (ArgP)__builtin_amdgcn_kernarg_segment_ptr();
#define AP() ({ ArgP p_ = argp; asm volatile("" : "+s"(p_)); p_; })
    unsigned char* ws = args.ws; float* out = args.out;
    const int lo = args.ph_lo, hi = args.ph_hi;
#define IN(k) (lo <= (k) && (k) < hi)
#ifndef PROBE_DUP
#define PROBE_DUP 0
#endif
#define REP(k) for (int rep_ = 0; rep_ <= ((PROBE_DUP >> (k)) & 1); ++rep_)
#define SEAM(k) do { if (IN(k) && IN((k) + 1)) { if ((k) == 0) grid.sync(); else { const int t_ = MYTID(); unsigned* gb_ = (unsigned*)args.ws + 1024; ctr_arrive(gb_, t_); ctr_wait(gb_, (unsigned)(G * (k)), t_); } } } while (0)
    bf16_t* R0 = (bf16_t*)(ws + WS_R0); bf16_t* R1 = (bf16_t*)(ws + WS_R1); bf16_t* R2 = (bf16_t*)(ws + WS_R2); bf16_t* HB = (bf16_t*)(ws + WS_HB);
    bf16_t* Ab = (bf16_t*)(ws + WS_A); bf16_t* Gb = (bf16_t*)(ws + WS_G); float* HF = out + O_Y;
    float* ssq0 = (float*)(ws + WS_SSQ0); float* ssq1 = (float*)(ws + WS_SSQ1); float* ssq2 = (float*)(ws + WS_SSQ2); float* ssq3 = (float*)(ws + WS_SSQ3);

    if (IN(0)) REP(0) { if (rep_) grid.sync(); TIDS();
        if (p0_prologue(AP(), lds, G, bx, tid, wave, lane, (unsigned*)ws + 2112)) {
            pg8::Gemm g{R0, (const bf16_t*)(ws + WS_WIN), T, 2 * D, D}; pg8::OneUnit S{TP / 256 + (bx >> 3), bx & 7};
            pg8::EpiSguIn E{ssq0, R1, R2, (float*)(ws + WS_VSTAT)};
            pg8::gemm_phase<pg8::EpiSguIn, pg8::OneUnit, true, true>(lds, g, S, E, wv0); } }
    SEAM(0);
    if (IN(1)) REP(1) { if (rep_) grid.sync();
        pg8::Gemm g{R0, (const bf16_t*)(ws + WS_WIN), T, 2 * D, D}; pg8::StaticOrder S; S.init(G >= 32 ? TP : T, 2 * D, G, vblk);
        pg8::EpiSguIn E{ssq0, R1, R2, (float*)(ws + WS_VSTAT)};
        pg8::gemm_phase<pg8::EpiSguIn, pg8::StaticOrder, true, true>(lds, g, S, E, wv0);
    }
    SEAM(1);
    if (IN(2)) REP(2) { if (rep_) grid.sync(); TIDS();
        unsigned* q2 = (unsigned*)ws + 320; unsigned* c_sgus = (unsigned*)ws + 384; unsigned* c_p3s = (unsigned*)ws + 448;
        LAS unsigned* ubox = (LAS unsigned*)(lds + RING_BYTES);
        constexpr unsigned S_A = 64, S_B = S_A + 256, S_C = S_B + 8, S_D = S_C + 512, S_E = S_D + 44, S_END = S_E + 256;
        for (;;) {
            if (wave == 0) ubox[0] = (unsigned)__builtin_amdgcn_readfirstlane((int)__hip_atomic_fetch_add(q2, lane == 0 ? 1u : 0u, __ATOMIC_RELAXED, __HIP_MEMORY_SCOPE_AGENT));
            __syncthreads();
            const unsigned un = (unsigned)__builtin_amdgcn_readfirstlane((int)ubox[0]);
            __syncthreads();
            if (un >= S_END) break;
            int v;
            if (un < S_A) { sgu_unit(AP(), lds, 1024 + (int)un, tid, wave, lane); ctr_arrive(c_sgus, tid); continue; }
            else if (un < S_B) v = (int)(un - S_A);
            else if (un < S_C) { const int k = (int)(un - S_B); ctr_wait(c_sgus, 64u, tid);
                pg8::Gemm g{Gb, (const bf16_t*)(ws + WS_WOUT), T, D, D}; pg8::OneUnit S{TP / 256 + (k >> 2), k & 3}; pg8::EpiRes<false> E{R0, HB, ssq1, nullptr};
                pg8::gemm_phase<pg8::EpiRes<false>, pg8::OneUnit, true, true>(lds, g, S, E, wv0);
                ctr_arrive(c_p3s, tid); continue; }
            else if (un < S_D) v = (int)(un - S_C) + 256;
            else if (un < S_E) { const int k = (int)(un - S_D); ctr_wait(c_p3s, 8u, tid);
                pg8::Gemm g{HB, (const bf16_t*)(ws + WS_WUP0), T, DFF2, D}; pg8::OneUnit S{TP / 256 + k / 22, k % 22}; pg8::EpiUp<true> E{ssq1, Ab, Gb, (float*)(ws + WS_A), out + O_CONVP, out + O_CONVS, AP()->in[15], AP()->in[16]};
                pg8::gemm_phase<pg8::EpiUp<true>, pg8::OneUnit, true, true>(lds, g, S, E, wv0);
                continue; }
            else v = (int)(un - S_E) + 768;
            sgu_unit(AP(), lds, v, tid, wave, lane);
        }
    }
    SEAM(2);
    if (IN(3)) REP(3) { if (rep_) grid.sync();
        pg8::Gemm g{Gb, (const bf16_t*)(ws + WS_WOUT), T, D, D}; pg8::StaticOrder S; S.init(TP, D, G, vblk);
        pg8::EpiRes<false> E{R0, HB, ssq1, nullptr};
        pg8::gemm_phase<pg8::EpiRes<false>, pg8::StaticOrder, true, true>(lds, g, S, E, wv0);
    }
    SEAM(3);
    if (IN(4)) REP(4) { if (rep_) grid.sync();
        pg8::Gemm g{HB, (const bf16_t*)(ws + WS_WUP0), T, DFF2, D}; pg8::StaticOrder S; S.init(TP, DFF2, G, vblk);
        pg8::EpiUp<false> E{ssq1, Ab, Gb, (float*)(ws + WS_A), out + O_CONVP, out + O_CONVS, AP()->in[15], AP()->in[16]};
        pg8::gemm_phase<pg8::EpiUp<false>, pg8::StaticOrder, true, true>(lds, g, S, E, wv0);
    }
    SEAM(4);
    if (IN(5)) REP(5) { if (rep_) grid.sync(); TIDS();
        if (conv_phase(AP(), 0, G, tid, bx, (unsigned*)ws + 64)) {
            const int un_ = bx >> 2, qk = bx & 3, koff = qk < 2 ? qk * 768 : 1536 + (qk - 2) * 640, klen = qk < 2 ? 768 : 640;
            float* part = (float*)(ws + WS_R1) + (size_t)un_ * 3 * 65536; unsigned* pc = (unsigned*)ws + 1088 + 64 * un_;
            pg8::Gemm g{Gb + koff, (const bf16_t*)(ws + WS_WDN0) + koff, T, D, DFF, klen}; pg8::OneUnit S{TP / 256 + (un_ >> 2), un_ & 3};
            if (qk < 3) { pg8::EpiPart E{part + (size_t)qk * 65536, pc}; pg8::gemm_phase<pg8::EpiPart, pg8::OneUnit, true, true>(lds, g, S, E, wv0); }
            else { pg8::EpiRes<false, true> E{HB, HB, ssq2, nullptr, part, pc}; pg8::gemm_phase<pg8::EpiRes<false, true>, pg8::OneUnit, true, true>(lds, g, S, E, wv0); } } }
    SEAM(5);
    if (IN(6)) REP(6) { if (rep_) grid.sync();
        pg8::Gemm g{Gb, (const bf16_t*)(ws + WS_WDN0), T, D, DFF}; pg8::StaticOrder S; S.init(G >= 64 ? TP : T, D, G, vblk);
        pg8::EpiRes<false> E{HB, HB, ssq2, nullptr};
        pg8::gemm_phase<pg8::EpiRes<false>, pg8::StaticOrder, true, true>(lds, g, S, E, wv0);
    }
    SEAM(6);
    if (IN(7)) REP(7) { if (rep_) grid.sync();
        pg8::Gemm g{HB, (const bf16_t*)(ws + WS_WQKV), T, 3 * D, D}; pg8::StaticOrder S; S.init(T, 3 * D, G, vblk);
        pg8::EpiQKV E{ssq2, R0, R1, R2, out + O_KP, out + O_KS, out + O_VP, out + O_VS, AP()->in[25], AP()->in[21], C2};
        pg8::gemm_phase<pg8::EpiQKV, pg8::StaticOrder, true, true>(lds, g, S, E, wv0);
        { TIDS(); logf_units(AP(), gw, NGW, lane); }
    }
    SEAM(7);
    if (IN(8)) REP(8) { if (rep_) grid.sync();
        TIDS(); LAS float* sh = (LAS float*)lds;
        for (int un = bx; un < NBP * NH + NBS * NH; un += G) {
            if (un < NBP * NH) { const int b = un >> 4, h = un & 15;
                float mg8;
                { float a_ = fabsf(AP()->in[25][lane]), b_ = fabsf(AP()->in[21][lane]);
#pragma unroll
                    for (int o = 1; o < 64; o <<= 1) { a_ = fmaxf(a_, __shfl_xor(a_, o)); b_ = fmaxf(b_, __shfl_xor(b_, o)); }
                    mg8 = 64.f * C2 * a_ * b_ * 1.02f; }
                scan_unit(out + O_LFP + (size_t)b * SEQP * NH + h, SEQP, NH, nullptr, 0, 0, (float*)(ws + WS_CKP) + (size_t)un * SEQP, sh, tid, wave, lane, (int*)(ws + 32768) + un * 32, 2.f * mg8 + 150.f); }
            else { const int us = un - NBP * NH, s = us >> 4, h = us & 15;
                scan_unit(AP()->in[4] + (size_t)s * PAST * NH + h, PAST, NH, out + O_LFS + (size_t)s * SEQS * NH + h, SEQS, NH, (float*)(ws + WS_CKS) + (size_t)us * SKS, sh, tid, wave, lane); }
        }
    }
    SEAM(8);
    if (IN(9)) REP(9) { if (rep_) grid.sync();
        TIDS();
        unsigned* qctr = (unsigned*)ws;
        LAS unsigned* ubox = (LAS unsigned*)(lds + RING_BYTES);
        float mg;
        { const float gq = fabsf(AP()->in[25][lane]), gk = fabsf(AP()->in[21][lane]); float a_ = gq, b_ = gk;
#pragma unroll
            for (int o = 1; o < 64; o <<= 1) { a_ = fmaxf(a_, __shfl_xor(a_, o)); b_ = fmaxf(b_, __shfl_xor(b_, o)); }
            mg = 64.f * C2 * a_ * b_ * 1.02f; }
        constexpr unsigned Q_A = 1024, Q_B = Q_A + 8, Q_C = Q_B + 512, Q_D = Q_C + 44, Q_END = Q_D + 768, Q_S = NBS * NH;
        unsigned* c_attn = (unsigned*)ws + 192; unsigned* c_wo = (unsigned*)ws + 256;
        for (;;) {
            if (wave == 0) ubox[0] = (unsigned)__builtin_amdgcn_readfirstlane((int)__hip_atomic_fetch_add(qctr, lane == 0 ? 1u : 0u, __ATOMIC_RELAXED, __HIP_MEMORY_SCOPE_AGENT));
            __syncthreads();
            const unsigned un = (unsigned)__builtin_amdgcn_readfirstlane((int)ubox[0]);
            __syncthreads();
            if (un >= Q_END) break;
            int v;
            if (un < Q_A) {
                if ((un & 3u) == 0u) { const int su = (int)(un >> 2); int t2 = MYTID(); asm volatile("" : "+v"(t2));
                    attn_sample_unit(AP(), su >> 4, su & 15, lds, t2, __builtin_amdgcn_readfirstlane(t2 >> 6), t2 & 63); ctr_arrive(c_attn, t2); continue; }
                v = (int)(un >> 2) * 3 + (int)(un & 3u) - 1;
            }
            else if (un < Q_B) {
                const int k = (int)(un - Q_A); ctr_wait(c_attn, Q_S, tid);
                pg8::Gemm g{R0, (const bf16_t*)(ws + WS_WO), T, D, D}; pg8::OneUnit S{TP / 256 + (k >> 2), k & 3}; pg8::EpiRes<false> E{HB, HB, ssq3, nullptr};
                pg8::gemm_phase<pg8::EpiRes<false>, pg8::OneUnit, true, true>(lds, g, S, E, wv0);
                ctr_arrive(c_wo, tid); continue; }
            else if (un < Q_C) v = (int)(un - Q_B) + 768;
            else if (un < Q_D) {
                const int k = (int)(un - Q_C); ctr_wait(c_wo, 8u, tid);
                pg8::Gemm g{HB, (const bf16_t*)(ws + WS_WUP1), T, DFF2, D}; pg8::OneUnit S{TP / 256 + k / 22, k % 22};
                pg8::EpiUp<true> E{ssq3, Ab, Gb, (float*)(ws + WS_A), out + O_CONVP + (size_t)NBP * 2 * DFF2, out + O_CONVS + (size_t)NBS * 2 * DFF2, AP()->in[15] + (size_t)3 * DFF2, AP()->in[16] + DFF2};
                pg8::gemm_phase<pg8::EpiUp<true>, pg8::OneUnit, true, true>(lds, g, S, E, wv0);
                continue; }
            else v = (int)(un - Q_D) + 1280;
            const int qb = 31 - (v >> 6), bh = v & 63, q0 = qb * 256;
            const int kt0 = __builtin_amdgcn_readfirstlane(((const int*)(ws + 32768))[bh * 32 + qb]);
            { const f32x4* src = (const f32x4*)((const float*)(ws + WS_CKP) + (size_t)bh * SEQP); LAS f32x4* dst = (LAS f32x4*)(lds + attn_body::LDS_BIAS);
                for (int k = 16 * kt0 + tid; k < (q0 + 256) / 4; k += NTHR) dst[k] = src[k]; }
            __syncthreads();
            attn_body::attn_unit<40>(wv0, bh >> 4, bh & 15, qb, kt0, (const attn_body::bf16*)R0, (const attn_body::bf16*)R1, (const attn_body::bf16*)R2, (attn_body::bf16*)R0, (char*)lds_raw);
        }
    }
    SEAM(9);
    if (IN(10)) REP(10) { if (rep_) grid.sync();
        pg8::Gemm g{R0, (const bf16_t*)(ws + WS_WO), T, D, D}; pg8::StaticOrder S; S.init(TP, D, G, vblk);
        pg8::EpiRes<false> E{HB, HB, ssq3, nullptr};
        pg8::gemm_phase<pg8::EpiRes<false>, pg8::StaticOrder, true, true>(lds, g, S, E, wv0);
    }
    SEAM(10);
    if (IN(11)) REP(11) { if (rep_) grid.sync();
        pg8::Gemm g{HB, (const bf16_t*)(ws + WS_WUP1), T, DFF2, D}; pg8::StaticOrder S; S.init(TP, DFF2, G, vblk);
        pg8::EpiUp<false> E{ssq3, Ab, Gb, (float*)(ws + WS_A), out + O_CONVP + (size_t)NBP * 2 * DFF2, out + O_CONVS + (size_t)NBS * 2 * DFF2, AP()->in[15] + (size_t)3 * DFF2, AP()->in[16] + DFF2};
        pg8::gemm_phase<pg8::EpiUp<false>, pg8::StaticOrder, true, true>(lds, g, S, E, wv0);
    }
    SEAM(11);
    if (IN(12)) REP(12) { if (rep_) grid.sync(); TIDS();
        if (conv_phase(AP(), 1, G, tid, bx, (unsigned*)ws + 128)) {
            const int un_ = bx >> 2, qk = bx & 3, koff = qk < 2 ? qk * 768 : 1536 + (qk - 2) * 640, klen = qk < 2 ? 768 : 640;
            float* part = (float*)(ws + WS_R1) + (size_t)un_ * 3 * 65536; unsigned* pc = (unsigned*)ws + 1088 + 64 * (8 + un_);
            pg8::Gemm g{Gb + koff, (const bf16_t*)(ws + WS_WDN1) + koff, T, D, DFF, klen}; pg8::OneUnit S{TP / 256 + (un_ >> 2), un_ & 3};
            if (qk < 3) { pg8::EpiPart E{part + (size_t)qk * 65536, pc}; pg8::gemm_phase<pg8::EpiPart, pg8::OneUnit, true, true>(lds, g, S, E, wv0); }
            else { pg8::EpiRes<true, true> E{HB, nullptr, nullptr, HF, part, pc}; pg8::gemm_phase<pg8::EpiRes<true, true>, pg8::OneUnit, true, true>(lds, g, S, E, wv0); } } }
    SEAM(12);
    if (IN(13)) REP(13) { if (rep_) grid.sync();
        pg8::Gemm g{Gb, (const bf16_t*)(ws + WS_WDN1), T, D, DFF}; pg8::StaticOrder S; S.init(G >= 64 ? TP : T, D, G, vblk);
        pg8::EpiRes<true> E{HB, nullptr, nullptr, HF};
        pg8::gemm_phase<pg8::EpiRes<true>, pg8::StaticOrder, true, true>(lds, g, S, E, wv0);
    }
#undef IN
#undef SEAM
}

#ifndef MK_N_LAUNCHES
#define MK_N_LAUNCHES 1
#endif
extern "C" void kernel_launch(void* const* d_in, const int* in_sizes, int n_in, void* d_out, int out_size, void* d_ws, size_t ws_size, hipStream_t stream) {
    static int grid = 0;
    if (grid == 0) {
        if (n_in != 27 || (size_t)out_size != O_END || ws_size < WS_END) { fprintf(stderr, "kernel_launch: unexpected shapes (n_in %d out %d ws %zu)\n", n_in, out_size, ws_size); grid = -1; return; }
        int dev = 0, cus = 0, per_cu = 0;
        hipGetDevice(&dev); hipDeviceGetAttribute(&cus, hipDeviceAttributeMultiprocessorCount, dev);
        if (hipFuncSetAttribute((const void*)yoco_fwd, hipFuncAttributeMaxDynamicSharedMemorySize, LDS_BYTES) != hipSuccess) { fprintf(stderr, "kernel_launch: hipFuncSetAttribute failed\n"); grid = -1; return; }
        if (hipOccupancyMaxActiveBlocksPerMultiprocessor(&per_cu, (const void*)yoco_fwd, NTHR, LDS_BYTES) != hipSuccess || per_cu < 1) { fprintf(stderr, "kernel_launch: occupancy query says %d\n", per_cu); per_cu = 1; }
        (void)hipGetLastError();
        grid = cus * 1;
    }
    if (grid < 0) return;
    if (hipMemsetAsync(d_ws, 0, 16384, stream) != hipSuccess) { fprintf(stderr, "kernel_launch: hipMemsetAsync failed\n"); return; }
    Args a{};
    for (int i = 0; i < 27; ++i) a.in[i] = (const float*)d_in[i];
    a.out = (float*)d_out; a.ws = (unsigned char*)d_ws;
    constexpr int NL = MK_N_LAUNCHES;
    for (int li = 0; li < NL; ++li) {
        a.ph_lo = (NL == 1) ? 0 : li; a.ph_hi = (NL == 1) ? NPHASE : li + 1;
        void* kargs[] = {&a};
        hipError_t e = hipLaunchCooperativeKernel((const void*)yoco_fwd, dim3(grid), dim3(NTHR), kargs, LDS_BYTES, stream);
        if (e != hipSuccess) { fprintf(stderr, "kernel_launch: cooperative launch failed: %s (grid %d)\n", hipGetErrorString(e), grid); break; }
    }
}
```

```cpp
#include <hip/hip_runtime.h>
#include <hip/hip_cooperative_groups.h>
#include <cstdio>
#include <cstdint>
namespace pg8 {
#define PG8_LAS __attribute__((address_space(3)))
typedef unsigned short bf16_t;
typedef short bf16x8 __attribute__((ext_vector_type(8)));
typedef float f32x4 __attribute__((ext_vector_type(4)));
typedef unsigned u32x4 __attribute__((ext_vector_type(4)));
constexpr int BM = 256, BK = 64, HALF = 128, HTB = HALF * BK * 2  , STAGE_BYTES = 8 * HTB, NXCD = 8, WGM = 8;

__host__ __device__ __forceinline__ int lds_byte(int r, int c) { const int st = (r >> 4) * 2 + (c >> 5), rr = r & 15, cc = c & 31, ob = rr * 64 + cc * 2; return st * 1024 + (ob ^ (((ob >> 9) & 1) << 5)); }
__host__ __device__ __forceinline__ void stage_rc(int b, int& R, int& C) { const int st = b / 1024, sb = b % 1024, swz = sb ^ (((sb >> 9) & 1) << 5); R = (st >> 1) * 16 + swz / 64; C = (st & 1) * 32 + (swz % 64) / 2; }
__host__ __device__ __forceinline__ int perm32(int rho) { const int n = rho >> 4, i = rho & 15; return 8 * (i >> 2) + 4 * n + (i & 3); }

struct Unit { int pm, pn; };
struct Gemm { const bf16_t* A; const bf16_t* Bt; int M, N, K, KL; };

struct StaticOrder {
    int nM, nN, nwg, G, c;
    __host__ __device__ void init(int M, int N, int G_, int c_) { nM = M / BM; nN = N / BM; nwg = nM * nN; G = G_; c = c_; }
    __host__ __device__ bool next(int i, Unit& u) const {
        const long L = (long)i * G + c; if (L >= nwg) return false;
        int wgid = (int)L; { const int q = nwg / NXCD, r = nwg % NXCD, xcd = wgid % NXCD, off = wgid / NXCD; wgid = (xcd < r ? xcd * (q + 1) : r * (q + 1) + (xcd - r) * q) + off; }
        const int nig = WGM * nN, gid = wgid / nig, fm = gid * WGM, gsz = (nM - fm) < WGM ? (nM - fm) : WGM;
        u.pm = fm + ((wgid % nig) % gsz); u.pn = (wgid % nig) / gsz; return true;
    }
    __device__ __forceinline__ void a_ready(const Unit&) const {}
    __device__ __forceinline__ void done(const Unit&) const {}
};

__device__ __forceinline__ unsigned cvt_pk_bf16(float lo, float hi) { unsigned r; asm volatile("v_cvt_pk_bf16_f32 %0, %1, %2" : "=v"(r) : "v"(lo), "v"(hi)); return r; }
typedef float f32x2 __attribute__((ext_vector_type(2)));
template <class Epi, class Sched, bool ALIGN_EPI = false, bool SP2 = false>
__device__ __forceinline__ void gemm_phase(PG8_LAS unsigned char* lds, const Gemm g, const Sched& S, const Epi& E, const int wv0) {
    int tid_ = (wv0 << 6) | (int)__builtin_amdgcn_mbcnt_hi(~0u, __builtin_amdgcn_mbcnt_lo(~0u, 0u)); asm volatile("" : "+v"(tid_));
    const int tid = tid_, wid = __builtin_amdgcn_readfirstlane(tid >> 6), lane = tid & 63, wr = wid >> 2, wc = wid & 3, fr = lane & 15, fq = lane >> 4;
    const int K = g.K, nt = (g.KL ? g.KL : K) / BK;
    unsigned voffA[2], voffB[2];
#pragma unroll
    for (int i = 0; i < 2; ++i) { int R, C; stage_rc(tid * 16 + i * 8192, R, C); const int Rb = Epi::PERM ? ((R & ~31) + perm32(R & 31)) : R;
        voffA[i] = (unsigned)(R * K + C) * 2u; voffB[i] = (unsigned)(Rb * K + C) * 2u; }
    const size_t kstep = (size_t)(BK * 2);
    const size_t hstep = (size_t)HALF * K * 2;
    const size_t tstep = 2 * hstep;
    const unsigned ldsw = (unsigned)wid * 1024u;
    const int aoff = lds_byte(wr * 64 + fr, fq * 8), boff = lds_byte(wc * 32 + fr, fq * 8);
#define PG8_SA(b, h) (((b) * 2 + (h)) * HTB)
#define PG8_SB(b, h) ((4 + (b) * 2 + (h)) * HTB)
#define PG8_STAGE(bufoff, gbase, voff) do { _Pragma("unroll") for (int _i = 0; _i < 2; ++_i) \
        __builtin_amdgcn_global_load_lds((const unsigned*)((const char*)(gbase) + (voff)[_i]), (PG8_LAS unsigned*)(lds + (bufoff) + ldsw + _i * 8192), 16, 0, 0); } while (0)
#define PG8_LDA(dst, b, h) do { _Pragma("unroll") for (int m = 0; m < 4; ++m) _Pragma("unroll") for (int k = 0; k < 2; ++k) dst[m][k] = *(const PG8_LAS bf16x8*)(lds + PG8_SA(b, h) + aoff + m * 2048 + k * 1024); } while (0)
#define PG8_LDB(dst, b, h) do { _Pragma("unroll") for (int n = 0; n < 2; ++n) _Pragma("unroll") for (int k = 0; k < 2; ++k) dst[n][k] = *(const PG8_LAS bf16x8*)(lds + PG8_SB(b, h) + boff + n * 2048 + k * 1024); } while (0)
#define PG8_MMA(ai, bj, At, Bt) do { __builtin_amdgcn_s_setprio(1); _Pragma("unroll") for (int m = 0; m < 4; ++m) _Pragma("unroll") for (int n = 0; n < 2; ++n) _Pragma("unroll") for (int k = 0; k < 2; ++k) \
        acc[ai][bj][m][n] = __builtin_amdgcn_mfma_f32_16x16x32_bf16(Bt[n][k], At[m][k], acc[ai][bj][m][n], 0, 0, 0); __builtin_amdgcn_s_setprio(0); } while (0)
#define PG8_WAIT_V(n) asm volatile("s_waitcnt vmcnt(" #n ")" ::: "memory")
#define PG8_WAIT_L(n) asm volatile("s_waitcnt lgkmcnt(" #n ")" ::: "memory")
#define PG8_BAR __builtin_amdgcn_s_barrier()
#define PG8_SCHED __builtin_amdgcn_sched_barrier(0)
    Unit cur, nxt; int ui = 0;
    if (!S.next(0, cur)) return;
    f32x4 acc[2][2][4][2];
#pragma unroll
    for (int a = 0; a < 2; ++a)
#pragma unroll
        for (int b = 0; b < 2; ++b)
#pragma unroll
            for (int m = 0; m < 4; ++m)
#pragma unroll
                for (int n = 0; n < 2; ++n) acc[a][b][m][n] = (f32x4){0.f, 0.f, 0.f, 0.f};
    bf16x8 At[4][2], B0[2][2], B1[2][2];
    const char* cA = (const char*)g.A + (size_t)cur.pm * tstep; const char* cB = (const char*)g.Bt + (size_t)cur.pn * tstep;
    S.a_ready(cur);
    if constexpr (SP2) {
        PG8_STAGE(PG8_SB(0, 0), cB, voffB); PG8_STAGE(PG8_SB(0, 1), cB + hstep, voffB); PG8_STAGE(PG8_SA(0, 0), cA, voffA); PG8_STAGE(PG8_SA(0, 1), cA + hstep, voffA);
        if (wr == 1) PG8_BAR;
        PG8_WAIT_V(2); PG8_BAR;
        PG8_STAGE(PG8_SB(1, 0), cB + kstep, voffB); PG8_STAGE(PG8_SA(1, 0), cA + kstep, voffA); PG8_STAGE(PG8_SB(1, 1), cB + hstep + kstep, voffB);
        PG8_WAIT_V(6); PG8_BAR;
    } else {
        PG8_STAGE(PG8_SB(0, 0), cB, voffB); PG8_STAGE(PG8_SA(0, 0), cA, voffA); PG8_STAGE(PG8_SB(0, 1), cB + hstep, voffB); PG8_STAGE(PG8_SA(0, 1), cA + hstep, voffA);
        if (wr == 1) PG8_BAR;
        PG8_WAIT_V(4); PG8_BAR;
        PG8_STAGE(PG8_SB(1, 0), cB + kstep, voffB); PG8_STAGE(PG8_SA(1, 0), cA + kstep, voffA); PG8_STAGE(PG8_SB(1, 1), cB + hstep + kstep, voffB);
        PG8_WAIT_V(6); PG8_BAR;
    }
    for (;;) {
        const bool has_next = S.next(ui + 1, nxt);
        const char* nA = has_next ? (const char*)g.A + (size_t)nxt.pm * tstep : cA; const char* nB = has_next ? (const char*)g.Bt + (size_t)nxt.pn * tstep : cB;
        for (int t = 0; t < nt; t += 2) {
            const bool last = (t == nt - 2);
            const char* a1 = cA + (size_t)(t + 1) * kstep;
            const char* a2 = last ? nA : cA + (size_t)(t + 2) * kstep; const char* b2 = last ? nB : cB + (size_t)(t + 2) * kstep;
            const char* a3 = a2 + kstep; const char* b3 = b2 + kstep;
            if (last && has_next) S.a_ready(nxt);
            if constexpr (SP2) {
            PG8_LDB(B0, 0, 0); PG8_LDB(B1, 0, 1); PG8_SCHED; PG8_LDA(At, 0, 0); PG8_STAGE(PG8_SA(1, 1), a1 + hstep, voffA);
            PG8_WAIT_V(8); PG8_WAIT_L(0); PG8_BAR; PG8_MMA(0, 0, At, B0); PG8_MMA(0, 1, At, B1); PG8_BAR; PG8_SCHED;
            PG8_LDA(At, 0, 1); PG8_STAGE(PG8_SB(0, 0), b2, voffB); PG8_STAGE(PG8_SB(0, 1), b2 + hstep, voffB); PG8_STAGE(PG8_SA(0, 0), a2, voffA);
            PG8_WAIT_V(8); PG8_WAIT_L(0); PG8_BAR; PG8_MMA(1, 0, At, B0); PG8_MMA(1, 1, At, B1); PG8_BAR; PG8_SCHED;
            PG8_LDB(B0, 1, 0); PG8_LDB(B1, 1, 1); PG8_SCHED; PG8_LDA(At, 1, 0); PG8_STAGE(PG8_SA(0, 1), a2 + hstep, voffA);
            PG8_WAIT_V(8); PG8_WAIT_L(0); PG8_BAR; PG8_MMA(0, 0, At, B0); PG8_MMA(0, 1, At, B1); PG8_BAR; PG8_SCHED;
            PG8_LDA(At, 1, 1); PG8_STAGE(PG8_SB(1, 0), b3, voffB); PG8_STAGE(PG8_SB(1, 1), b3 + hstep, voffB); PG8_STAGE(PG8_SA(1, 0), a3, voffA);
            PG8_WAIT_V(8); PG8_WAIT_L(0); PG8_BAR; PG8_MMA(1, 0, At, B0); PG8_MMA(1, 1, At, B1); PG8_BAR; PG8_SCHED;
            } else {
            PG8_LDB(B0, 0, 0); PG8_SCHED; PG8_LDA(At, 0, 0); PG8_STAGE(PG8_SA(1, 1), a1 + hstep, voffA);
            PG8_WAIT_L(8); PG8_BAR; PG8_WAIT_L(0); PG8_MMA(0, 0, At, B0); PG8_BAR; PG8_SCHED;
            PG8_LDB(B1, 0, 1); PG8_STAGE(PG8_SB(0, 0), b2, voffB);
            PG8_BAR; PG8_WAIT_L(0); PG8_MMA(0, 1, At, B1); PG8_BAR;
            PG8_LDA(At, 0, 1); PG8_STAGE(PG8_SA(0, 0), a2, voffA);
            PG8_BAR; PG8_WAIT_L(0); PG8_MMA(1, 0, At, B0); PG8_BAR; PG8_SCHED;
            PG8_STAGE(PG8_SB(0, 1), b2 + hstep, voffB);
            PG8_WAIT_V(6); PG8_BAR; PG8_MMA(1, 1, At, B1); PG8_BAR;
            PG8_LDB(B0, 1, 0); PG8_SCHED; PG8_LDA(At, 1, 0); PG8_STAGE(PG8_SA(0, 1), a2 + hstep, voffA);
            PG8_WAIT_L(8); PG8_BAR; PG8_WAIT_L(0); PG8_MMA(0, 0, At, B0); PG8_BAR; PG8_SCHED;
            PG8_LDB(B1, 1, 1); PG8_STAGE(PG8_SB(1, 0), b3, voffB);
            PG8_BAR; PG8_WAIT_L(0); PG8_MMA(0, 1, At, B1); PG8_BAR;
            PG8_LDA(At, 1, 1); PG8_STAGE(PG8_SA(1, 0), a3, voffA);
            PG8_BAR; PG8_WAIT_L(0); PG8_MMA(1, 0, At, B0); PG8_BAR; PG8_SCHED;
            PG8_STAGE(PG8_SB(1, 1), b3 + hstep, voffB);
            PG8_WAIT_V(6); PG8_BAR; PG8_MMA(1, 1, At, B1); PG8_BAR;
            }
        }
        if constexpr (ALIGN_EPI) { if (wr == 0) PG8_BAR; }
        if constexpr (!Epi::AFTER_DRAIN) { E(acc, cur, wr, wc, fr, fq); S.done(cur); }
        if (!has_next) break;
#pragma unroll
        for (int a = 0; a < 2; ++a)
#pragma unroll
            for (int b = 0; b < 2; ++b)
#pragma unroll
                for (int m = 0; m < 4; ++m)
#pragma unroll
                    for (int n = 0; n < 2; ++n) acc[a][b][m][n] = (f32x4){0.f, 0.f, 0.f, 0.f};
        cur = nxt; cA = nA; cB = nB; ++ui;
        if constexpr (ALIGN_EPI) { if (wr == 1) PG8_BAR; }
    }
    PG8_WAIT_V(0);
    if constexpr (!ALIGN_EPI) { if (wr == 0) PG8_BAR; }
    PG8_BAR;
    if constexpr (Epi::AFTER_DRAIN) { E.fused(acc, cur, wr, wc, fr, fq, lds, wid, lane); S.done(cur); }
#undef PG8_SA
#undef PG8_SB
#undef PG8_STAGE
#undef PG8_LDA
#undef PG8_LDB
#undef PG8_MMA
#undef PG8_WAIT_V
#undef PG8_WAIT_L
#undef PG8_BAR
#undef PG8_SCHED
}
}
namespace pg8 {
constexpr int TP = 32768;
constexpr float RMS_EPS = 1e-6f;
typedef unsigned u32x2 __attribute__((ext_vector_type(2)));
__device__ __forceinline__ float quad_sum(float s) { s += __shfl_xor(s, 16); s += __shfl_xor(s, 32); return s; }
__device__ __forceinline__ float row_rstd(const float* ssq, int row, int fq) {
    const f32x4 p = *(const f32x4*)(ssq + (size_t)row * 16 + 4 * fq);
    const float s = quad_sum((p[0] + p[1]) + (p[2] + p[3]));
    return __builtin_amdgcn_rsqf(s * (1.0f / 1024.0f) + RMS_EPS);
}
__device__ __forceinline__ void rows_rstd(float (&rs)[2][4], const float* ssq, int rowb, int fq) {
#pragma unroll
    for (int ai = 0; ai < 2; ++ai) {
        f32x4 p[4];
#pragma unroll
        for (int m = 0; m < 4; ++m) p[m] = *(const f32x4*)(ssq + (size_t)(rowb + ai * HALF + m * 16) * 16 + 4 * fq);
#pragma unroll
        for (int m = 0; m < 4; ++m) { const float s = quad_sum((p[m][0] + p[m][1]) + (p[m][2] + p[m][3])); rs[ai][m] = __builtin_amdgcn_rsqf(s * (1.0f / 1024.0f) + RMS_EPS); }
        __builtin_amdgcn_sched_barrier(0);
    }
}
__device__ __forceinline__ float gelu_tanh(float x) {
    const float y = 0.7978845608028654f * (x + 0.044715f * x * x * x);
    return x * __builtin_amdgcn_rcpf(1.0f + __builtin_amdgcn_exp2f(-2.8853900817779268f * y));
}
__device__ __forceinline__ u32x2 pack4(const f32x4 v) { u32x2 w; w.x = cvt_pk_bf16(v[0], v[1]); w.y = cvt_pk_bf16(v[2], v[3]); return w; }

struct EpiSguIn {
    static constexpr bool PERM = false, AFTER_DRAIN = false;
    const float* ssq; bf16_t* U; bf16_t* VP; float* vstat;
    __device__ __forceinline__ void operator()(const f32x4 (&acc)[2][2][4][2], const Unit& u, int wr, int wc, int fr, int fq) const {
        const bool isv = u.pn >= 4; bf16_t* O = isv ? +VP : +U; const int col0 = (u.pn & 3) * BM + wc * 32 + 4 * fq;
        float rsv[2][4]; rows_rstd(rsv, ssq, u.pm * BM + wr * 64 + fr, fq);
#pragma unroll
        for (int ai = 0; ai < 2; ++ai)
#pragma unroll
            for (int m = 0; m < 4; ++m) {
                const int row = u.pm * BM + ai * HALF + wr * 64 + m * 16 + fr; const float rstd = rsv[ai][m];
                float s = 0.f, s2 = 0.f; bf16_t* rowp = O + (size_t)row * 1024 + col0;
#pragma unroll
                for (int bj = 0; bj < 2; ++bj)
#pragma unroll
                    for (int n = 0; n < 2; ++n) { f32x4 v = acc[ai][bj][m][n] * rstd;
                        v[0] = gelu_tanh(v[0]); v[1] = gelu_tanh(v[1]); v[2] = gelu_tanh(v[2]); v[3] = gelu_tanh(v[3]);
                        s += (v[0] + v[1]) + (v[2] + v[3]); s2 += (v[0] * v[0] + v[1] * v[1]) + (v[2] * v[2] + v[3] * v[3]);
                        *(u32x2*)(rowp + bj * HALF + n * 16) = pack4(v); }
                if (isv) { s = quad_sum(s); s2 = quad_sum(s2);
                    if (fq == 0) { float* p = vstat + ((size_t)row * 16 + (u.pn - 4) * 4 + wc) * 2; p[0] = s; p[1] = s2; } }
            }
    }
};
__device__ __forceinline__ void part_arrive(unsigned* ctr, int tid) {
    asm volatile("s_waitcnt vmcnt(0)" ::: "memory"); __syncthreads();
    if (__builtin_amdgcn_readfirstlane(tid >> 6) == 0) { __builtin_amdgcn_fence(__ATOMIC_RELEASE, "agent"); asm volatile("s_waitcnt vmcnt(0)" ::: "memory");
        __hip_atomic_fetch_add(ctr, (tid & 63) == 0 ? 1u : 0u, __ATOMIC_RELAXED, __HIP_MEMORY_SCOPE_AGENT); }
}
__device__ __forceinline__ void part_wait(unsigned* ctr, unsigned need, int tid) {
    if (__builtin_amdgcn_readfirstlane(tid >> 6) == 0) {
        while ((unsigned)__builtin_amdgcn_readfirstlane((int)__hip_atomic_load(ctr, __ATOMIC_RELAXED, __HIP_MEMORY_SCOPE_AGENT)) < need) __builtin_amdgcn_s_sleep(2);
        __builtin_amdgcn_fence(__ATOMIC_ACQUIRE, "agent"); asm volatile("s_waitcnt vmcnt(0)" ::: "memory"); }
    __syncthreads();
}
struct EpiPart {
    static constexpr bool PERM = true, AFTER_DRAIN = false;
    float* part; unsigned* ctr;
    __device__ __forceinline__ void operator()(const f32x4 (&acc)[2][2][4][2], const Unit&, int wr, int wc, int fr, int fq) const {
        const int tid = ((wr * 4 + wc) << 6) | (fq * 16 + fr); f32x4* p = (f32x4*)part + tid;
#pragma unroll
        for (int ai = 0; ai < 2; ++ai)
#pragma unroll
            for (int bj = 0; bj < 2; ++bj)
#pragma unroll
                for (int m = 0; m < 4; ++m)
#pragma unroll
                    for (int n = 0; n < 2; ++n) p[(((ai * 2 + bj) * 4 + m) * 2 + n) * 512] = acc[ai][bj][m][n];
        part_arrive(ctr, tid);
    }
};
__device__ __forceinline__ void add_partials(const f32x4 (&acc)[2][2][4][2], const float* part, unsigned* ctr, int wr, int wc, int fr, int fq) {
    const int tid = ((wr * 4 + wc) << 6) | (fq * 16 + fr); part_wait(ctr, 3u, tid); asm volatile("" ::: "memory"); __builtin_amdgcn_sched_barrier(0);
    f32x4 (&ac)[2][2][4][2] = const_cast<f32x4 (&)[2][2][4][2]>(acc);
#pragma unroll 1
    for (int pk = 2; pk >= 0; --pk) {
        const f32x4* p = (const f32x4*)part + (size_t)pk * 16384 + tid;
#pragma unroll
        for (int ai = 0; ai < 2; ++ai)
#pragma unroll
            for (int bj = 0; bj < 2; ++bj)
#pragma unroll
                for (int m = 0; m < 4; ++m)
#pragma unroll
                    for (int n = 0; n < 2; ++n) { ac[ai][bj][m][n] = p[(((ai * 2 + bj) * 4 + m) * 2 + n) * 512] + ac[ai][bj][m][n];
                        if (n == 1 && (m & 1)) { asm volatile("" : "+v"(ac[ai][bj][m - 1][0]), "+v"(ac[ai][bj][m - 1][1]), "+v"(ac[ai][bj][m][0]), "+v"(ac[ai][bj][m][1]) :: "memory"); __builtin_amdgcn_sched_barrier(0); } }
    }
}
template <bool FINAL, bool PART = false> struct EpiRes {
    static constexpr bool PERM = true, AFTER_DRAIN = false;
    const bf16_t* hin; bf16_t* hb; float* ssq; float* yout;
    const float* part; unsigned* ctr;
    __device__ __forceinline__ void operator()(const f32x4 (&acc)[2][2][4][2], const Unit& u, int wr, int wc, int fr, int fq) const {
        if constexpr (PART) add_partials(acc, part, ctr, wr, wc, fr, fq);
        const int col0 = u.pn * BM + wc * 32 + 8 * fq, rowb = u.pm * BM + wr * 64 + fr;
        u32x4 pre[3][2];
#define EPIRES_LOAD(g, buf) do { const bf16_t* hi_ = hin + (size_t)(rowb + ((g) >> 2) * HALF + ((g) & 3) * 16) * 1024 + col0; \
            pre[buf][0] = *(const u32x4*)(hi_); pre[buf][1] = *(const u32x4*)(hi_ + HALF); } while (0)
        EPIRES_LOAD(0, 0); EPIRES_LOAD(1, 1);
#pragma unroll
        for (int g = 0; g < 8; ++g) {
            if (g + 2 < 8) EPIRES_LOAD(g + 2, (g + 2) % 3);
            const int ai = g >> 2, m = g & 3, row = rowb + ai * HALF + m * 16; float s2 = 0.f;
#pragma unroll
            for (int bj = 0; bj < 2; ++bj) { const u32x4 r = pre[g % 3][bj];
                const f32x4 v0 = acc[ai][bj][m][0] + (f32x4){__uint_as_float(r.x << 16), __uint_as_float(r.x & 0xffff0000u), __uint_as_float(r.y << 16), __uint_as_float(r.y & 0xffff0000u)};
                const f32x4 v1 = acc[ai][bj][m][1] + (f32x4){__uint_as_float(r.z << 16), __uint_as_float(r.z & 0xffff0000u), __uint_as_float(r.w << 16), __uint_as_float(r.w & 0xffff0000u)};
                if (FINAL) { float* yo = yout + (size_t)row * 1024 + col0 + bj * HALF; __builtin_nontemporal_store(v0, (f32x4*)yo); __builtin_nontemporal_store(v1, (f32x4*)(yo + 4)); }
                else { u32x4 w; w.x = cvt_pk_bf16(v0[0], v0[1]); w.y = cvt_pk_bf16(v0[2], v0[3]); w.z = cvt_pk_bf16(v1[0], v1[1]); w.w = cvt_pk_bf16(v1[2], v1[3]);
                    *(u32x4*)(hb + (size_t)row * 1024 + col0 + bj * HALF) = w;
                    s2 += ((v0[0] * v0[0] + v0[1] * v0[1]) + (v0[2] * v0[2] + v0[3] * v0[3])) + ((v1[0] * v1[0] + v1[1] * v1[1]) + (v1[2] * v1[2] + v1[3] * v1[3])); } }
            if (!FINAL) { s2 = quad_sum(s2); if (fq == 0) ssq[(size_t)row * 16 + u.pn * 4 + wc] = s2; }
        }
#undef EPIRES_LOAD
    }
};
template <int S> __device__ __forceinline__ float dpp_prev(float prevm, float cur) {
    const int o = __builtin_amdgcn_update_dpp(0, __builtin_bit_cast(int, prevm), 0x120 + S, 0xf, 0xf, true);
    return __builtin_bit_cast(float, __builtin_amdgcn_update_dpp(o, __builtin_bit_cast(int, cur), 0x110 + S, 0xf, 0xf, false));
}
template <int S> __device__ __forceinline__ float dpp_first(float cur) {
    return __builtin_bit_cast(float, __builtin_amdgcn_update_dpp(0, __builtin_bit_cast(int, cur), 0x110 + S, 0xf, 0xf, true));
}
template <bool SAMPLE> struct EpiUp {
    static constexpr bool PERM = false, AFTER_DRAIN = false;
    const float* ssq; bf16_t* A; bf16_t* Gout; float* stash; float* convP; float* convS; const float* cw; const float* cb;
    __device__ __forceinline__ void operator()(const f32x4 (&acc)[2][2][4][2], const Unit& u, int wr, int wc, int fr, int fq) const {
        float rsv[2][4]; rows_rstd(rsv, ssq, u.pm * BM + wr * 64 + fr, fq);
        const int cbase = u.pn * 128 + wc * 32 + 4 * fq;
        if constexpr (SAMPLE) {
#pragma unroll
            for (int ai = 0; ai < 2; ++ai)
#pragma unroll
                for (int m = 0; m < 4; ++m) {
                    const int row = u.pm * BM + ai * HALF + wr * 64 + m * 16 + fr; const float rstd = rsv[ai][m];
                    float* tp = nullptr; { const int rs = row - TP, t = rs & 31; if (t >= 30) tp = convS + (size_t)((rs >> 5) * 2 + (t - 30)) * 5632; }
                    bf16_t* ap = A + (size_t)row * 5632;
#pragma unroll
                    for (int bj = 0; bj < 2; ++bj)
#pragma unroll
                        for (int n = 0; n < 2; ++n) { const f32x4 v = acc[ai][bj][m][n] * rstd; const int cl = bj * 2816 + cbase + 16 * n; *(u32x2*)(ap + cl) = pack4(v);
                            if (tp) *(f32x4*)(tp + cl) = v; }
                }
        } else {
        typedef float f32x2v __attribute__((ext_vector_type(2)));
        f32x2v wc_[8], wn_[8];
#define UPW_LOAD(dst, gi_) do { const int Jh_ = cbase + 16 * ((gi_) >> 1) + 2 * ((gi_) & 1); \
            dst[0] = *(const f32x2v*)(cw + Jh_); dst[1] = *(const f32x2v*)(cw + 5632 + Jh_); dst[2] = *(const f32x2v*)(cw + 2 * 5632 + Jh_); dst[3] = *(const f32x2v*)(cb + Jh_); \
            dst[4] = *(const f32x2v*)(cw + 2816 + Jh_); dst[5] = *(const f32x2v*)(cw + 5632 + 2816 + Jh_); dst[6] = *(const f32x2v*)(cw + 2 * 5632 + 2816 + Jh_); dst[7] = *(const f32x2v*)(cb + 2816 + Jh_); } while (0)
        UPW_LOAD(wc_, 0);
        f32x4 (&ac)[2][2][4][2] = const_cast<f32x4 (&)[2][2][4][2]>(acc);
#pragma unroll
        for (int ai = 0; ai < 2; ++ai)
#pragma unroll
            for (int m = 0; m < 4; ++m)
#pragma unroll
                for (int bj = 0; bj < 2; ++bj)
#pragma unroll
                    for (int n = 0; n < 2; ++n) ac[ai][bj][m][n] = ac[ai][bj][m][n] * rsv[ai][m];
        asm volatile("" ::: "memory"); __builtin_amdgcn_sched_barrier(0);
        unsigned pk0[2][4];
#pragma unroll
        for (int gi = 0; gi < 4; ++gi) {
            const int n = gi >> 1, jh = gi & 1, J = cbase + 16 * n;
            const f32x2v w0g = wc_[0], w1g = wc_[1], w2g = wc_[2], bg = wc_[3], w0v = wc_[4], w1v = wc_[5], w2v = wc_[6], bv = wc_[7];
#pragma unroll
            for (int ai = 0; ai < 2; ++ai) {
                if (ai == 1 && gi < 3) UPW_LOAD(wn_, gi + 1);
#pragma unroll
                for (int m = 0; m < 4; ++m) {
                    const int row = u.pm * BM + ai * HALF + wr * 64 + m * 16 + fr;
                    float og[2];
#pragma unroll
                    for (int e = 0; e < 2; ++e) {
                        const float xg = ac[ai][0][m][n][2 * jh + e], xv = ac[ai][1][m][n][2 * jh + e];
                        float g1, g2, v1, v2;
                        if (m == 0) { g1 = dpp_first<1>(xg); g2 = dpp_first<2>(xg); v1 = dpp_first<1>(xv); v2 = dpp_first<2>(xv); }
                        else { const float pg = ac[ai][0][m ? m - 1 : 0][n][2 * jh + e], pv = ac[ai][1][m ? m - 1 : 0][n][2 * jh + e];
                            g1 = dpp_prev<1>(pg, xg); g2 = dpp_prev<2>(pg, xg); v1 = dpp_prev<1>(pv, xv); v2 = dpp_prev<2>(pv, xv); }
                        const float cg = xg * w2g[e] + g1 * w1g[e] + g2 * w0g[e] + bg[e], cv = xv * w2v[e] + v1 * w1v[e] + v2 * w0v[e] + bv[e];
                        og[e] = cg * __builtin_amdgcn_rcpf(1.0f + __builtin_amdgcn_exp2f(-1.4426950408889634f * cg)) * cv;
                    }
                    const unsigned pk = cvt_pk_bf16(og[0], og[1]);
                    if (jh == 0) pk0[ai][m] = pk;
                    else {
                        if (!(m == 0 && fr < 2)) { u32x2 w; w.x = pk0[ai][m]; w.y = pk; *(u32x2*)(Gout + (size_t)row * 2816 + J) = w; }
                        if ((m == 0 && fr < 2) || (m == 3 && fr >= 14)) {
                            const f32x4 xg4 = ac[ai][0][m][n], xv4 = ac[ai][1][m][n];
                            float* sp = stash + (((size_t)(row >> 6) * 4 + (m == 0 ? fr : fr - 12)) * 2) * 2816 + J; *(f32x4*)sp = xg4; *(f32x4*)(sp + 2816) = xv4;
                            if (m == 3 && (row & 8191) >= 8190) { float* tp = convP + (size_t)((row >> 13) * 2 + ((row & 8191) - 8190)) * 5632; *(f32x4*)(tp + J) = xg4; *(f32x4*)(tp + 2816 + J) = xv4; } }
                    }
                    asm volatile("" ::: "memory"); __builtin_amdgcn_sched_barrier(0);
                }
            }
#pragma unroll
            for (int k = 0; k < 8; ++k) wc_[k] = wn_[k];
        }
#undef UPW_LOAD
        }
    }
};
struct EpiQKV {
    static constexpr bool PERM = false, AFTER_DRAIN = false;
    const float* ssq; bf16_t* Q; bf16_t* K; bf16_t* V; float* koP; float* koS; float* voP; float* voS; const float* qg; const float* kg; float c2;
    __device__ __forceinline__ void operator()(const f32x4 (&acc)[2][2][4][2], const Unit& u, int wr, int wc, int fr, int fq) const {
        const int t = u.pn >> 2, head = (u.pn & 3) * 4 + wc, colh = head * 64 + 4 * fq;
        const float* qg_ = qg; const float* kg_ = kg; bf16_t* Q_ = Q; bf16_t* K_ = K; bf16_t* V_ = V;
        asm volatile("" : "+s"(qg_), "+s"(kg_), "+s"(Q_), "+s"(K_), "+s"(V_));
        f32x4 gv[2][2];
#pragma unroll
        for (int bj = 0; bj < 2; ++bj)
#pragma unroll
            for (int n = 0; n < 2; ++n) gv[bj][n] = (t < 2) ? *(const f32x4*)((t == 0 ? qg_ : kg_) + 32 * bj + 16 * n + 4 * fq) : (f32x4){1.f, 1.f, 1.f, 1.f};
        bf16_t* B = t == 0 ? Q_ : (t == 1 ? K_ : V_);
        float rsv[2][4]; rows_rstd(rsv, ssq, u.pm * BM + wr * 64 + fr, fq);
#pragma unroll
        for (int ai = 0; ai < 2; ++ai)
#pragma unroll
            for (int m = 0; m < 4; ++m) {
                const int row = u.pm * BM + ai * HALF + wr * 64 + m * 16 + fr; const float rstd = rsv[ai][m];
                f32x4 v[2][2]; float ss = 0.f;
#pragma unroll
                for (int bj = 0; bj < 2; ++bj)
#pragma unroll
                    for (int n = 0; n < 2; ++n) { v[bj][n] = acc[ai][bj][m][n] * rstd; const f32x4 x = v[bj][n]; ss += (x[0] * x[0] + x[1] * x[1]) + (x[2] * x[2] + x[3] * x[3]); }
                float rs = 1.f;
                if (t < 2) { ss = quad_sum(ss); rs = __builtin_amdgcn_rsqf(ss * (1.0f / 64.0f) + RMS_EPS); if (t == 0) rs *= c2; }
                float* fo = nullptr;
                if (t == 1) fo = (row < TP ? koP + (size_t)row * 1024 : koS + (size_t)(row - TP) * 1024) + colh;
                if (t == 2) fo = (row < TP ? voP + (size_t)row * 1024 : voS + (size_t)(row - TP) * 1024) + colh;
                bf16_t* bo = B + (size_t)row * 1024 + colh;
#pragma unroll
                for (int bj = 0; bj < 2; ++bj)
#pragma unroll
                    for (int n = 0; n < 2; ++n) { const f32x4 o = v[bj][n] * rs * gv[bj][n]; *(u32x2*)(bo + 32 * bj + 16 * n) = pack4(o);
                        if (fo) __builtin_nontemporal_store(o, (f32x4*)(fo + 32 * bj + 16 * n)); }
            }
    }
};
struct OneUnit { int pm, pn;
    __device__ __forceinline__ bool next(int i, Unit& u) const { if (i != 0) return false; u.pm = pm; u.pn = pn; return true; }
    __device__ __forceinline__ void a_ready(const Unit&) const {}
    __device__ __forceinline__ void done(const Unit&) const {}
};
}
#include <hip/hip_bf16.h>
#include <cmath>
namespace attn_body {
using bf16=__hip_bfloat16;
using bf16x8=__attribute__((ext_vector_type(8)))short;
using s16x4=__attribute__((ext_vector_type(4)))short;
using f32x16=__attribute__((ext_vector_type(16)))float;
using u32x4=__attribute__((ext_vector_type(4)))unsigned;
constexpr int BATCH=4,NHEAD=16,SEQ=8192,D=64,DM=NHEAD*D;
constexpr int NW=8,QBLK=32,QB=QBLK*NW,KVBLK=64,NQB=SEQ/QB;
constexpr int ATTN_PITCH=DM, ATTN_UNIT_ROWS=QB;
__device__ __forceinline__ int crow(int r,int hi){return (r&3)+8*(r>>2)+4*hi;}
#define SBAR() __builtin_amdgcn_sched_barrier(0)
__device__ __forceinline__ void cmask(f32x16&p0,f32x16&p1,int jb,int qrel,int hi){
  const float NEG=-INFINITY; int kb=64*jb+4*hi;
  #pragma unroll
  for(int r=0;r<16;++r){int kv=kb+(r&3)+8*(r>>2); if(kv>qrel)p0[r]=NEG; if(kv+32>qrel)p1[r]=NEG;}
}

constexpr int NSLOT=3, SLOTB=8192, LDS_BIAS=86016;
constexpr int LDS_K=0, LDS_V=NSLOT*SLOTB, LDS_WS=2*NSLOT*SLOTB, LDS_OST=LDS_WS+NW*64*4, LDS_BYTES=LDS_OST+NW*4096;
constexpr float C2=0.125f*1.4426950408889634f;
__device__ __forceinline__ void glds16(const void*gsrc,unsigned lds_dst){unsigned keep;
  asm volatile("s_mov_b32 %0, m0\n\ts_mov_b32 m0, %2\n\ts_nop 0\n\tglobal_load_lds_dwordx4 %1, off\n\ts_mov_b32 m0, %0":"=&s"(keep):"v"(gsrc),"s"(lds_dst):"memory");}
__device__ __forceinline__ float max3f(float a,float b,float c){float r;asm("v_max3_f32 %0, %1, %2, %3":"=v"(r):"v"(a),"v"(b),"v"(c));return r;}
__device__ __forceinline__ float max2f(float a,float b){float r;asm("v_max_f32_e32 %0, %1, %2":"=v"(r):"v"(a),"v"(b));return r;}
__device__ __forceinline__ float fadd_s(float a,float b){float r;asm("v_add_f32_e32 %0, %1, %2":"=v"(r):"v"(a),"v"(b));return r;}
__device__ __forceinline__ float fsub_s(float a,float b){float r;asm("v_sub_f32_e32 %0, %1, %2":"=v"(r):"v"(a),"v"(b));return r;}
typedef float f32x2_t __attribute__((ext_vector_type(2))); typedef __bf16 bf16x2_t __attribute__((ext_vector_type(2)));
__device__ __forceinline__ unsigned cvtpk_s(float lo,float hi){f32x2_t v={lo,hi};bf16x2_t b=__builtin_convertvector(v,bf16x2_t);return __builtin_bit_cast(unsigned,b);}
#define WAIT_BAR(N) asm volatile("s_waitcnt vmcnt(" #N ") lgkmcnt(0)\n\ts_barrier":::"memory")

__device__ __forceinline__ void qkt(f32x16&p0,f32x16&p1,const char*Kslot,const bf16x8*qr,int r32,int hi){
  const char*kb=Kslot+hi*1024+r32*16;
  #pragma unroll
  for(int d0=0;d0<4;++d0){
    const bf16x8 b0=*reinterpret_cast<const bf16x8*>(kb+d0*2048);
    const bf16x8 b1=*reinterpret_cast<const bf16x8*>(kb+d0*2048+512);
    if(d0==0){p0=__builtin_amdgcn_mfma_f32_32x32x16_bf16(b0,qr[0],p0,0,0,0);p1=__builtin_amdgcn_mfma_f32_32x32x16_bf16(b1,qr[0],p1,0,0,0);}
    else{p0=__builtin_amdgcn_mfma_f32_32x32x16_bf16(b0,qr[d0],p0,0,0,0);p1=__builtin_amdgcn_mfma_f32_32x32x16_bf16(b1,qr[d0],p1,0,0,0);}}
}
typedef __attribute__((address_space(3))) const char* lds_cptr;
typedef short v4i16_t __attribute__((ext_vector_type(4)));
__device__ __forceinline__ void kload8(bf16x8*kf,lds_cptr kp){
  kf[0]=*(const __attribute__((address_space(3))) bf16x8*)(kp);      kf[1]=*(const __attribute__((address_space(3))) bf16x8*)(kp+512);
  kf[2]=*(const __attribute__((address_space(3))) bf16x8*)(kp+2048); kf[3]=*(const __attribute__((address_space(3))) bf16x8*)(kp+2560);
  kf[4]=*(const __attribute__((address_space(3))) bf16x8*)(kp+4096); kf[5]=*(const __attribute__((address_space(3))) bf16x8*)(kp+4608);
  kf[6]=*(const __attribute__((address_space(3))) bf16x8*)(kp+6144); kf[7]=*(const __attribute__((address_space(3))) bf16x8*)(kp+6656);
}
__device__ __forceinline__ void kload2(bf16x8*kf,lds_cptr kp,int j){ kf[2*j]=*(const __attribute__((address_space(3))) bf16x8*)(kp+j*2048); kf[2*j+1]=*(const __attribute__((address_space(3))) bf16x8*)(kp+j*2048+512); }
__device__ __forceinline__ s16x4 vtr(lds_cptr p){ return __builtin_bit_cast(s16x4,__builtin_amdgcn_ds_read_tr16_b64_v4i16((__attribute__((address_space(3))) v4i16_t*)p)); }
__device__ __forceinline__ float rowmax(const f32x16&p0,const f32x16&p1){
  float a=max3f(p0[0],p0[1],p1[0]),b=max3f(p0[2],p0[3],p1[1]);a=max3f(a,p1[2],p1[3]);
  #pragma unroll
  for(int r=4;r<16;r+=4){a=max3f(a,p0[r],p0[r+1]);b=max3f(b,p0[r+2],p0[r+3]);a=max3f(a,p1[r],p1[r+1]);b=max3f(b,p1[r+2],p1[r+3]);}
  const float m=max2f(a,b);
  auto rr=__builtin_amdgcn_permlane32_swap(__float_as_uint(m),__float_as_uint(m),false,false);
  return max2f(__uint_as_float(rr[0]),__uint_as_float(rr[1]));
}
__device__ __forceinline__ void pv(f32x16*o,int vb,bf16x8 pa0,bf16x8 pa1,bf16x8 pa2,bf16x8 pa3){
  #pragma unroll
  for(int d0=0;d0<2;++d0){s16x4 lo[4],hi[4];
    #pragma unroll
    for(int ks=0;ks<4;++ks){
      asm volatile("ds_read_b64_tr_b16 %0,%1 offset:%c2":"=&v"(lo[ks]):"v"(vb),"i"(d0*4096+ks*1024):"memory");
      asm volatile("ds_read_b64_tr_b16 %0,%1 offset:%c2":"=&v"(hi[ks]):"v"(vb),"i"(d0*4096+ks*1024+512):"memory");}
    asm volatile("s_waitcnt lgkmcnt(0)":::"memory");SBAR();
    #define PK(k) (bf16x8){lo[k][0],lo[k][1],lo[k][2],lo[k][3],hi[k][0],hi[k][1],hi[k][2],hi[k][3]}
    o[d0]=__builtin_amdgcn_mfma_f32_32x32x16_bf16(pa0,PK(0),o[d0],0,0,0);
    o[d0]=__builtin_amdgcn_mfma_f32_32x32x16_bf16(pa1,PK(1),o[d0],0,0,0);
    o[d0]=__builtin_amdgcn_mfma_f32_32x32x16_bf16(pa2,PK(2),o[d0],0,0,0);
    o[d0]=__builtin_amdgcn_mfma_f32_32x32x16_bf16(pa3,PK(3),o[d0],0,0,0);
    #undef PK
  }
}

#ifndef ATTN_STORE16
#define ATTN_STORE16(p,v) (*(u32x4*)(p)=(v))
#endif
template<int THRL> __device__ __forceinline__ void attn_unit(int wv0,int b,int h,int qb,int kt0,const bf16*Q,const bf16*__restrict__ K,const bf16*__restrict__ V,bf16*O,char*shm){
  int tid_=(wv0<<6)|(int)__builtin_amdgcn_mbcnt_hi(~0u,__builtin_amdgcn_mbcnt_lo(~0u,0u)); asm volatile("":"+v"(tid_)); const int tid=tid_,lane=tid&63,r32=lane&31,hi=lane>>5; const int wid=__builtin_amdgcn_readfirstlane(tid>>6);
  const long rowbase=(long)b*SEQ; const int q0=qb*QB;
  const bf16*Qw=Q+(rowbase+q0+wid*QBLK)*DM+h*D;
  const bf16*Kh=K+(rowbase+(long)kt0*KVBLK)*DM+h*D,*Vh=V+(rowbase+(long)kt0*KVBLK)*DM+h*D;
  const unsigned lds0=(unsigned)(uintptr_t)shm;
  float*wsf=(float*)(shm+LDS_WS)+wid*64;
  const bf16*ksrc=Kh+(long)lane*DM+wid*8;
  const bf16*vsrc=Vh+(long)(16*(wid&3)+(lane>>2))*DM+(wid>>2)*32+(lane&3)*8;
  const unsigned kdst=lds0+LDS_K+wid*1024, vdst=lds0+LDS_V+wid*1024;
  #define DMA_K(t,slot) glds16(ksrc+(long)(t)*KVBLK*DM,(unsigned)__builtin_amdgcn_readfirstlane(kdst+(slot)))
  #define DMA_V(t,slot) glds16(vsrc+(long)(t)*KVBLK*DM,(unsigned)__builtin_amdgcn_readfirstlane(vdst+(slot)))
  const int vb0=(int)(lds0+LDS_V)+((lane>>4)&1)*32+(lane&3)*8+(4*hi+((lane&15)>>2))*64;
  const char*Kbase=shm+LDS_K; bf16x8 kf[8];
  const lds_cptr shm3=(lds_cptr)shm; const lds_cptr kp0=shm3+LDS_K+hi*1024+r32*16; const lds_cptr vp0=shm3+LDS_V+((lane>>4)&1)*32+(lane&3)*8+(4*hi+((lane&15)>>2))*64;
  const int NT=(q0+QB)/KVBLK-kt0;
  DMA_K(0,0);DMA_V(0,0);DMA_K(1,SLOTB);
  bf16x8 qr[4];
  #pragma unroll
  for(int d0=0;d0<4;++d0)qr[d0]=*reinterpret_cast<const bf16x8*>(&Qw[(long)r32*DM+d0*16+hi*8]);
  float mhat=0.f,l_reg=0.f;f32x16 o[2];o[0]=f32x16{};o[1]=f32x16{};
  typedef float f32x4v __attribute__((ext_vector_type(4))); typedef __attribute__((address_space(3))) const f32x4v* lds_f4p;
  const lds_f4p bias4=(lds_f4p)((__attribute__((address_space(3))) const char*)shm+LDS_BIAS)+hi+(kt0)*16;
  #define CINIT(C0,C1,t) do{ const lds_f4p bp_=bias4+(t)*16; \
    _Pragma("unroll") for(int g_=0;g_<4;++g_){ const f32x4v x_=bp_[2*g_], y_=bp_[8+2*g_]; \
      C0[4*g_]=x_[0]-mhat; C0[4*g_+1]=x_[1]-mhat; C0[4*g_+2]=x_[2]-mhat; C0[4*g_+3]=x_[3]-mhat; \
      C1[4*g_]=y_[0]-mhat; C1[4*g_+1]=y_[1]-mhat; C1[4*g_+2]=y_[2]-mhat; C1[4*g_+3]=y_[3]-mhat; } }while(0)

  const int qrel=wid*QBLK+r32;
  #define CMASK(P0,P1,t) do{int jb_=(t)-(NT-4); if(jb_>=0)cmask(P0,P1,jb_,qrel,hi);}while(0)
  bool resc=false;
  #define START(P0,P1) do{ const float rm=rowmax(P0,P1); resc=false; \
    { const float dl=rm; mhat=fadd_s(mhat,dl); \
      _Pragma("unroll") for(int r=0;r<16;++r){P0[r]=fsub_s(P0[r],dl);P1[r]=fsub_s(P1[r],dl);} \
       } \
    _Pragma("unroll") for(int r=0;r<16;++r)P0[r]=__builtin_amdgcn_exp2f(P0[r]); }while(0)
  #define RESC() do{ if(resc){ asm volatile("s_waitcnt lgkmcnt(0)":::"memory"); \
      _Pragma("unroll") for(int d_=0;d_<2;++d_) _Pragma("unroll") for(int r=0;r<16;++r)o[d_][r]*=wsf[crow(r,hi)]; } }while(0)
  f32x16 pA0,pA1,pB0,pB1;
  int sl_prev=0,sl_cur=0,sl_next=SLOTB;
  #define ROT() do{sl_prev=sl_cur;sl_cur=sl_next;sl_next=(sl_next==(NSLOT-1)*SLOTB)?0:sl_next+SLOTB;}while(0)
  DMA_K(2,2*SLOTB);
  WAIT_BAR(3);
  CINIT(pA0,pA1,0); qkt(pA0,pA1,Kbase,qr,r32,hi);asm volatile("s_nop 15\n\ts_nop 7":"+v"(pA0),"+v"(pA1));CMASK(pA0,pA1,0);
  START(pA0,pA1);
  _Pragma("unroll") for(int r=0;r<16;++r)pA1[r]=__builtin_amdgcn_exp2f(pA1[r]);
  WAIT_BAR(0);
  DMA_K(3,0);DMA_V(1,SLOTB);
  ROT();
  kload8(kf,kp0+sl_cur);
  WAIT_BAR(2);
  s16x4 vlo[8],vhi[8]; u32x4 pw0,pw1,pw2,pw3;
  #define PKW(P,B) cvtpk_s(P[B],P[B+1])
  #define PAF(k) __builtin_bit_cast(bf16x8,pw##k)
  #define VFR(i) (bf16x8){vlo[i][0],vlo[i][1],vlo[i][2],vlo[i][3],vhi[i][0],vhi[i][1],vhi[i][2],vhi[i][3]}
  #define PIN(x) asm volatile("":"+v"(x))
  #define MX3(a,b,c) __builtin_fmaxf(__builtin_fmaxf((a),(b)),(c))
  #define GAPA(MF,A0,A1,A2,A3,W0,W1,PW) do{ MF; sacc+=A0; sacc+=A1; sacc+=A2; sacc+=A3; PIN(sacc); W0; W1; PIN(PW); SBAR(); }while(0)
  #define EX(v) __builtin_amdgcn_exp2f(v)
  #define GAPB(MF,X,B) do{ MF; X[B]=EX(X[B]); X[B+1]=EX(X[B+1]); X[B+2]=EX(X[B+2]); X[B+3]=EX(X[B+3]); PIN(X); SBAR(); }while(0)
  #define VRD(i) do{ vlo[i]=vtr(vp_+(((i)>>2)*4096+((i)&3)*1024)); vhi[i]=vtr(vp_+(((i)>>2)*4096+((i)&3)*1024+512)); }while(0)
  #define KRD(G,j) do{ if(G){ kload2(kf,kp0+sl_next,j); SBAR(); } }while(0)
  #define STEP(C0,C1,P0,P1,t,GK,GV,GL) do{ SBAR(); CINIT(C0,C1,t); SBAR(); \
    const lds_cptr vp_=vp0+sl_prev; \
    VRD(0); SBAR(); float sacc=(P0[0]+P0[1]); \
    GAPA(C0=__builtin_amdgcn_mfma_f32_32x32x16_bf16(kf[0],qr[0],C0,0,0,0), P0[2],P0[3],P0[4],P0[5],     pw0[0]=PKW(P0,0), pw0[1]=PKW(P0,2), pw0); \
    VRD(4); SBAR(); GAPA(C1=__builtin_amdgcn_mfma_f32_32x32x16_bf16(kf[1],qr[0],C1,0,0,0), P0[6],P0[7],P0[8],P0[9],     pw0[2]=PKW(P0,4), pw0[3]=PKW(P0,6), pw0); \
    VRD(1); SBAR(); GAPA(C0=__builtin_amdgcn_mfma_f32_32x32x16_bf16(kf[2],qr[1],C0,0,0,0),   P0[10],P0[11],P0[12],P0[13], pw1[0]=PKW(P0,8), pw1[1]=PKW(P0,10), pw1); \
    VRD(5); SBAR(); GAPA(C1=__builtin_amdgcn_mfma_f32_32x32x16_bf16(kf[3],qr[1],C1,0,0,0),   P0[14],P0[15],P1[0],P1[1],   pw1[2]=PKW(P0,12),pw1[3]=PKW(P0,14), pw1); \
    VRD(2); SBAR(); GAPA(C0=__builtin_amdgcn_mfma_f32_32x32x16_bf16(kf[4],qr[2],C0,0,0,0),   P1[2],P1[3],P1[4],P1[5],     pw2[0]=PKW(P1,0), pw2[1]=PKW(P1,2), pw2); \
    VRD(6); SBAR(); GAPA(C1=__builtin_amdgcn_mfma_f32_32x32x16_bf16(kf[5],qr[2],C1,0,0,0),   P1[6],P1[7],P1[8],P1[9],     pw2[2]=PKW(P1,4), pw2[3]=PKW(P1,6), pw2); \
    VRD(3); SBAR(); GAPA(C0=__builtin_amdgcn_mfma_f32_32x32x16_bf16(kf[6],qr[3],C0,0,0,0),   P1[10],P1[11],P1[12],P1[13], pw3[0]=PKW(P1,8), pw3[1]=PKW(P1,10), pw3); \
    VRD(7); SBAR(); GAPA(C1=__builtin_amdgcn_mfma_f32_32x32x16_bf16(kf[7],qr[3],C1,0,0,0),   P1[14],P1[15],0.f,0.f,       pw3[2]=PKW(P1,12),pw3[3]=PKW(P1,14), pw3); \
    l_reg+=sacc; \
    if(GK){DMA_K((t)+3,sl_cur);} if(GV){DMA_V((t)+1,sl_next);} \
    CMASK(C0,C1,t); \
    { float a=MX3(C0[0],C0[1],C1[0]),b=MX3(C0[2],C0[3],C1[1]); a=MX3(a,C1[2],C1[3]); \
      _Pragma("unroll") for(int r=4;r<16;r+=4){a=MX3(a,C0[r],C0[r+1]);b=MX3(b,C0[r+2],C0[r+3]);a=MX3(a,C1[r],C1[r+1]);b=MX3(b,C1[r+2],C1[r+3]);} \
      float rm=__builtin_fmaxf(a,b); { auto rr=__builtin_amdgcn_permlane32_swap(__float_as_uint(rm),__float_as_uint(rm),false,false); rm=__builtin_fmaxf(__uint_as_float(rr[0]),__uint_as_float(rr[1])); } \
      resc=false; \
      if(__builtin_expect(__any(rm>(float)THRL),0)){ const float dl=__builtin_fmaxf(rm,0.f); mhat+=dl; \
        _Pragma("unroll") for(int r=0;r<16;++r){C0[r]-=dl;C1[r]-=dl;} \
         \
        const float f=__builtin_amdgcn_exp2f(-dl); l_reg*=f; if(hi==0)wsf[r32]=f; resc=true; } } \
    SBAR(); \
    GAPB(o[0]=__builtin_amdgcn_mfma_f32_32x32x16_bf16(PAF(0),VFR(0),o[0],0,0,0), C0,0); \
    GAPB(o[1]=__builtin_amdgcn_mfma_f32_32x32x16_bf16(PAF(0),VFR(4),o[1],0,0,0), C0,4); \
    KRD(GL,0); GAPB(o[0]=__builtin_amdgcn_mfma_f32_32x32x16_bf16(PAF(1),VFR(1),o[0],0,0,0), C0,8); \
    KRD(GL,1); GAPB(o[1]=__builtin_amdgcn_mfma_f32_32x32x16_bf16(PAF(1),VFR(5),o[1],0,0,0), C0,12); \
    KRD(GL,2); GAPB(o[0]=__builtin_amdgcn_mfma_f32_32x32x16_bf16(PAF(2),VFR(2),o[0],0,0,0), C1,0); \
    KRD(GL,3); GAPB(o[1]=__builtin_amdgcn_mfma_f32_32x32x16_bf16(PAF(2),VFR(6),o[1],0,0,0), C1,4); \
    GAPB(o[0]=__builtin_amdgcn_mfma_f32_32x32x16_bf16(PAF(3),VFR(3),o[0],0,0,0), C1,8); \
    GAPB(o[1]=__builtin_amdgcn_mfma_f32_32x32x16_bf16(PAF(3),VFR(7),o[1],0,0,0), C1,12); \
    }while(0)
  int t=1;
  #undef CMASK
  #define CMASK(P0,P1,t) do{}while(0)
  for(;t+5<NT;t+=2){
    STEP(pB0,pB1,pA0,pA1,t,true,true,true);     WAIT_BAR(2); RESC(); ROT();
    STEP(pA0,pA1,pB0,pB1,t+1,true,true,true);   WAIT_BAR(2); RESC(); ROT();
  }
  #undef CMASK
  #define CMASK(P0,P1,t) do{int jb_=(t)-(NT-4); if(jb_>=0)cmask(P0,P1,jb_,qrel,hi);}while(0)
  #define ENDW(tt) do{ if((tt)+3<NT){WAIT_BAR(2);} else if((tt)+2<NT){WAIT_BAR(1);} else {WAIT_BAR(0);} }while(0)
  for(;t+1<NT;t+=2){
    STEP(pB0,pB1,pA0,pA1,t,(t+3<NT),(t+1<NT),(t+1<NT));       ENDW(t);   RESC(); ROT();
    STEP(pA0,pA1,pB0,pB1,t+1,(t+4<NT),(t+2<NT),(t+2<NT));     ENDW(t+1); RESC(); ROT();
  }
  STEP(pB0,pB1,pA0,pA1,NT-1,false,false,false); RESC();
  { float sacc=pB0[0]+pB0[1]; _Pragma("unroll") for(int r=2;r<16;++r)sacc+=pB0[r]; _Pragma("unroll") for(int r=0;r<16;++r)sacc+=pB1[r]; l_reg+=sacc;
    pw0=(u32x4){PKW(pB0,0),PKW(pB0,2),PKW(pB0,4),PKW(pB0,6)};pw1=(u32x4){PKW(pB0,8),PKW(pB0,10),PKW(pB0,12),PKW(pB0,14)};pw2=(u32x4){PKW(pB1,0),PKW(pB1,2),PKW(pB1,4),PKW(pB1,6)};pw3=(u32x4){PKW(pB1,8),PKW(pB1,10),PKW(pB1,12),PKW(pB1,14)};
    SBAR(); pv(o,vb0+sl_cur,PAF(0),PAF(1),PAF(2),PAF(3)); }
  #undef PKW
  #undef PAF
  #undef VFR
  #undef PIN
  #undef MX3
  #undef GAPA
  #undef GAPB
  #undef EX
  #undef VRD
  #undef KRD
  #undef STEP
  #undef ENDW
  {auto rr=__builtin_amdgcn_permlane32_swap(__float_as_uint(l_reg),__float_as_uint(l_reg),false,false);l_reg=__uint_as_float(rr[0])+__uint_as_float(rr[1]);}
  if(hi==0)wsf[32+r32]=l_reg;asm volatile("s_waitcnt lgkmcnt(0)":::"memory");
  float rli[16];
  #pragma unroll
  for(int r=0;r<16;++r)rli[r]=__builtin_amdgcn_rcpf(wsf[32+crow(r,hi)]);
  bf16*Ow=O+(rowbase+q0+wid*QBLK)*DM+h*D;
  { bf16*stg=(bf16*)(shm+LDS_OST)+wid*2048;
    #pragma unroll
    for(int r=0;r<16;++r){const int orow=crow(r,hi);
      #pragma unroll
      for(int d0=0;d0<2;++d0)stg[orow*64+d0*32+r32]=__float2bfloat16(o[d0][r]*rli[r]);}
    asm volatile("s_waitcnt lgkmcnt(0)":::"memory");
    #pragma unroll
    for(int i=0;i<4;++i){const int row=i*8+(lane>>3),ch=lane&7; const u32x4 v=*(const u32x4*)(stg+row*64+ch*8); ATTN_STORE16(Ow+(long)row*DM+ch*8,v);} }
  asm volatile("s_waitcnt lgkmcnt(0)\n\ts_barrier":::"memory");
  #undef DMA_K
  #undef DMA_V
  #undef CMASK
  #undef START
  #undef RESC
  #undef ROT
  #undef CINIT
}
constexpr int ATTN_LDS_BYTES=LDS_BYTES;
#undef SBAR
#undef WAIT_BAR
}
namespace cg = cooperative_groups;
#define GAS __attribute__((address_space(1)))
#define LAS __attribute__((address_space(3)))
typedef unsigned short bf16_t;
typedef unsigned v4u __attribute__((ext_vector_type(4)));
typedef unsigned v2u __attribute__((ext_vector_type(2)));
typedef float f32x4 __attribute__((ext_vector_type(4)));
typedef float f32x16 __attribute__((ext_vector_type(16)));
typedef short bf16x8 __attribute__((ext_vector_type(8)));
constexpr int NWAVES = 8, NTHR = 512;
constexpr int TP = 32768, TS = 512, T = TP + TS, D = 1024, DFF = 2816, DFF2 = 5632, NH = 16, HD = 64;
constexpr int SEQP = 8192, SEQS = 32, PAST = 4096, SKS = PAST + SEQS, NBP = 4, NBS = 16;
constexpr float EPS = 1e-6f, LOG2E = 1.4426950408889634f, C2 = 0.125f * 1.4426950408889634f;
constexpr size_t O_Y = 0, O_SGUV = 34078720, O_CONVP = 34603008, O_CONVS = 34693120, O_KP = 35053568, O_VP = 68608000, O_LFP = 102162432,
                 O_KS = 102686720, O_VS = 103211008, O_LFS = 103735296, O_END = 103743488;
constexpr size_t MiB = 1u << 20;
constexpr size_t WS_WF = 1 * MiB, WS_WSM = WS_WF + 65536, WS_WIN = 2 * MiB, WS_WOUT = 6 * MiB, WS_WUP0 = 8 * MiB, WS_WUP1 = 19 * MiB, WS_WDN0 = 30 * MiB, WS_WDN1 = 36 * MiB,
                 WS_WQKV = 42 * MiB, WS_WO = 48 * MiB, WS_SSQ0 = 50 * MiB, WS_SSQ1 = 53 * MiB, WS_SSQ2 = 56 * MiB, WS_SSQ3 = 59 * MiB, WS_VSTAT = 62 * MiB,
                 WS_CKP = 67 * MiB, WS_CKS = 69 * MiB, WS_R0 = 74 * MiB, WS_R1 = 139 * MiB, WS_R2 = 204 * MiB, WS_HB = 269 * MiB, WS_A = 334 * MiB, WS_G = 692 * MiB, WS_END = 871 * MiB;
constexpr int RING_BYTES = 131072, LDS_BYTES = 147456;

__device__ __forceinline__ unsigned f2bf(float f) { unsigned u = __builtin_bit_cast(unsigned, f); return (u + 0x7fffu + ((u >> 16) & 1u)) >> 16; }
__device__ __forceinline__ unsigned pk2(float lo, float hi) { return pg8::cvt_pk_bf16(lo, hi); }
__device__ __forceinline__ float bflo(unsigned w) { return __uint_as_float(w << 16); }
__device__ __forceinline__ float bfhi(unsigned w) { return __uint_as_float(w & 0xffff0000u); }
#define LDS_WAIT() asm volatile("s_waitcnt lgkmcnt(0)" ::: "memory")
__device__ __forceinline__ float wave_sum(float v) {
#pragma unroll
    for (int o = 1; o < 64; o <<= 1) v += __shfl_xor(v, o);
    return v;
}

struct Args { const float* in[27]; float* out; unsigned char* ws; int ph_lo, ph_hi; };
typedef const __attribute__((address_space(4))) Args* ArgP;

__device__ __forceinline__ void transpose_item(const float* W, int K, int N, bf16_t* WT, const float* g, int mode, int row_off, LAS float* scr, int item, int lane) {
    const int nblk = N / 32, kb = item / nblk, nb = item % nblk, k0 = 64 * kb, n0 = 32 * nb;
    float wv[32];
#pragma unroll
    for (int i = 0; i < 32; ++i) wv[i] = W[(size_t)(k0 + 2 * i + (lane >> 5)) * N + n0 + (lane & 31)];
#pragma unroll
    for (int i = 0; i < 32; ++i) { const int kk = 2 * i + (lane >> 5); float w = wv[i]; if (g) w *= g[k0 + kk]; scr[kk * 33 + (lane & 31)] = w; }
    LDS_WAIT(); asm volatile("" ::: "memory");
    const int c = lane & 7;
#pragma unroll
    for (int j = 0; j < 4; ++j) { const int n = (lane >> 3) + 8 * j; const LAS float* s = scr + (8 * c) * 33 + n;
        v4u o; o.x = pk2(s[0 * 33], s[1 * 33]); o.y = pk2(s[2 * 33], s[3 * 33]); o.z = pk2(s[4 * 33], s[5 * 33]); o.w = pk2(s[6 * 33], s[7 * 33]);
        int nn = n0 + n; if (mode == 1) { const int l = nn & 255; nn = (nn & ~255) + 128 * ((l >> 5) & 1) + 32 * (l >> 6) + (l & 31); }
        if (mode == 3) { const int bj = nn >= DFF ? 1 : 0, q = nn - bj * DFF; nn = 256 * (q >> 7) + 128 * bj + (q & 127); }
        *(v4u*)(WT + (size_t)(row_off + nn) * K + k0 + 8 * c) = o; }
    LDS_WAIT(); asm volatile("" ::: "memory");
}
__device__ __forceinline__ void x_rows4(ArgP a, int m0, int lane) {
    bf16_t* XB = (bf16_t*)(a->ws + WS_R0); float* ssq0 = (float*)(a->ws + WS_SSQ0);
    const float* xr = m0 < TP ? a->in[0] + (size_t)m0 * D : a->in[1] + (size_t)(m0 - TP) * D;
    f32x4 v[4][4];
#pragma unroll
    for (int r = 0; r < 4; ++r)
#pragma unroll
        for (int j = 0; j < 4; ++j) v[r][j] = __builtin_nontemporal_load((const f32x4*)(xr + (size_t)r * D) + lane + 64 * j);
#pragma unroll
    for (int r = 0; r < 4; ++r) { float s = 0.f;
#pragma unroll
        for (int j = 0; j < 4; ++j) { s += (v[r][j][0] * v[r][j][0] + v[r][j][1] * v[r][j][1]) + (v[r][j][2] * v[r][j][2] + v[r][j][3] * v[r][j][3]);
            v2u o; o.x = pk2(v[r][j][0], v[r][j][1]); o.y = pk2(v[r][j][2], v[r][j][3]); ((v2u*)(XB + (size_t)(m0 + r) * D))[lane + 64 * j] = o; }
        s = wave_sum(s);
        if (lane < 16) ssq0[(size_t)(m0 + r) * 16 + lane] = lane == 0 ? s : 0.f; }
}
__device__ __forceinline__ bool p0_prologue(ArgP a, LAS unsigned char* lds, int G, int bx, int tid, int wave, int lane, unsigned* ctr) {
    unsigned char* ws = a->ws;
    LAS float* scr = (LAS float*)(lds + wave * 16384);
    constexpr int I_IN = 16 * 64, I_OUT = 16 * 32, I_UP = 16 * 176, I_DN = 44 * 32, I_SQ = 16 * 32;
    constexpr int NITEMS = I_OUT + 2 * I_UP + 2 * I_DN + 4 * I_SQ;
    const bool split = G >= 32;
    for (int it = bx * NWAVES + wave; it < I_IN + TS / 4; it += G * NWAVES) {
        if (it < I_IN) transpose_item(a->in[8], D, 2 * D, (bf16_t*)(ws + WS_WIN), a->in[6], 0, 0, scr, it, lane);
        else x_rows4(a, TP + 4 * (it - I_IN), lane);
    }
    if (split) { pg8::part_arrive(ctr, tid); if (bx < 16) { pg8::part_wait(ctr, (unsigned)G, tid); return true; } }
    const int skip = split ? 16 : 0, gw = (bx - skip) * NWAVES + wave, NGW = (G - skip) * NWAVES;
    for (int it = gw; it < NITEMS; it += NGW) {
        int r = it;
        if (r < I_OUT) { transpose_item(a->in[13], D, D, (bf16_t*)(ws + WS_WOUT), nullptr, 0, 0, scr, r, lane); continue; } r -= I_OUT;
        if (r < I_UP) { transpose_item(a->in[14], D, DFF2, (bf16_t*)(ws + WS_WUP0), a->in[7], 3, 0, scr, r, lane); continue; } r -= I_UP;
        if (r < I_UP) { transpose_item(a->in[14] + (size_t)D * DFF2, D, DFF2, (bf16_t*)(ws + WS_WUP1), a->in[7] + D, 3, 0, scr, r, lane); continue; } r -= I_UP;
        if (r < I_DN) { transpose_item(a->in[17], DFF, D, (bf16_t*)(ws + WS_WDN0), nullptr, 0, 0, scr, r, lane); continue; } r -= I_DN;
        if (r < I_DN) { transpose_item(a->in[17] + (size_t)DFF * D, DFF, D, (bf16_t*)(ws + WS_WDN1), nullptr, 0, 0, scr, r, lane); continue; } r -= I_DN;
        if (r < I_SQ) { transpose_item(a->in[24], D, D, (bf16_t*)(ws + WS_WQKV), a->in[6] + D, 1, 0, scr, r, lane); continue; } r -= I_SQ;
        if (r < I_SQ) { transpose_item(a->in[19], D, D, (bf16_t*)(ws + WS_WQKV), a->in[18], 1, D, scr, r, lane); continue; } r -= I_SQ;
        if (r < I_SQ) { transpose_item(a->in[20], D, D, (bf16_t*)(ws + WS_WQKV), a->in[18], 1, 2 * D, scr, r, lane); continue; } r -= I_SQ;
        transpose_item(a->in[26], D, D, (bf16_t*)(ws + WS_WO), nullptr, 0, 0, scr, r, lane);
    }
    { const int gt = gw * 64 + lane, NGT = NGW * 64; bf16_t* wf = (bf16_t*)(ws + WS_WF); bf16_t* wsm = (bf16_t*)(ws + WS_WSM);
        for (int e = gt; e < 16 * D; e += NGT) { const int n = e >> 10, k = e & 1023; wf[e] = (bf16_t)f2bf(a->in[22][k * 16 + n] * a->in[18][k]); }
        for (int e = gt; e < 4 * 128 * 128; e += NGT) { const int i = (e >> 7) & 127, j = e & 127; wsm[e] = (bf16_t)f2bf(((j >> 6) <= (i >> 6)) ? a->in[11][e] : 0.f); } }
    for (int m0 = gw * 4; m0 < TP; m0 += NGW * 4) x_rows4(a, m0, lane);
    return false;
}

__device__ __forceinline__ void sgu_unit(ArgP a, LAS unsigned char* lds, int un, int tid, int wave, int lane) {
    unsigned char* ws = a->ws;
    const bf16_t* U = (const bf16_t*)(ws + WS_R1); const bf16_t* VP = (const bf16_t*)(ws + WS_R2); bf16_t* SG = (bf16_t*)(ws + WS_G);
    const float* vstat = (const float*)(ws + WS_VSTAT); const bf16_t* wsm = (const bf16_t*)(ws + WS_WSM);
    const float* lng = a->in[9]; const float* lnb = a->in[10]; const float* bs = a->in[12];
    constexpr int VPITCH = 136;
    LAS bf16_t* VT = (LAS bf16_t*)lds; LAS float* st = (LAS float*)(lds + 256 * VPITCH * 2);
    {
        const int nb = un >> 2, g = un & 3; const bool smp = nb >= 256;
        const int row0 = smp ? TP + (nb - 256) * 32 : nb * 128, nrows = smp ? 32 : 128;
        if (tid < nrows) { const float* p = vstat + (size_t)(row0 + tid) * 32; float s = 0.f, s2 = 0.f;
#pragma unroll
            for (int k = 0; k < 16; ++k) { s += p[2 * k]; s2 += p[2 * k + 1]; }
            const float mean = s * (1.f / 1024.f), var = fmaxf(s2 * (1.f / 1024.f) - mean * mean, 0.f);
            st[2 * tid] = mean; st[2 * tid + 1] = __builtin_amdgcn_rsqf(var + EPS); }
        __syncthreads();
        const int fr0_ = lane & 15, fq0_ = lane >> 4, nit0_ = nrows >> 4; const bf16_t* wg0_ = wsm + (size_t)g * 128 * 128; bf16x8 wf0[8];
#pragma unroll
        for (int it = 0; it < 8; ++it) if (it < nit0_) wf0[it] = *(const bf16x8*)(wg0_ + (it * 16 + fr0_) * 128 + fq0_ * 8);
        const int jsh = smp ? 5 : 7;
        for (int it = tid; it < nrows * 32; it += NTHR) {
            const int j = it & (nrows - 1), cc = (it >> jsh) * 8, c = g * 256 + cc; const float mean = st[2 * j], rstd = st[2 * j + 1];
            const v4u raw = *(const v4u*)(VP + (size_t)(row0 + j) * D + c);
            const f32x4 g0 = *(const f32x4*)(lng + c), g1 = *(const f32x4*)(lng + c + 4), b0 = *(const f32x4*)(lnb + c), b1 = *(const f32x4*)(lnb + c + 4);
            float v[8];
            v[0] = (bflo(raw.x) - mean) * rstd * g0[0] + b0[0]; v[1] = (bfhi(raw.x) - mean) * rstd * g0[1] + b0[1];
            v[2] = (bflo(raw.y) - mean) * rstd * g0[2] + b0[2]; v[3] = (bfhi(raw.y) - mean) * rstd * g0[3] + b0[3];
            v[4] = (bflo(raw.z) - mean) * rstd * g1[0] + b1[0]; v[5] = (bfhi(raw.z) - mean) * rstd * g1[1] + b1[1];
            v[6] = (bflo(raw.w) - mean) * rstd * g1[2] + b1[2]; v[7] = (bfhi(raw.w) - mean) * rstd * g1[3] + b1[3];
            if (smp) { float* o = a->out + O_SGUV + (size_t)(row0 - TP + j) * D + c; *(f32x4*)o = (f32x4){v[0], v[1], v[2], v[3]}; *(f32x4*)(o + 4) = (f32x4){v[4], v[5], v[6], v[7]}; }
#pragma unroll
            for (int e = 0; e < 8; ++e) VT[(cc + e) * VPITCH + j] = (bf16_t)f2bf(v[e]);
        }
        __syncthreads();
        const int fr = lane & 15, fq = lane >> 4, nit = nrows >> 4, nks = nrows >> 5;
        f32x4 acc[8][2];
#pragma unroll
        for (int i = 0; i < 8; ++i) { acc[i][0] = (f32x4){0.f, 0.f, 0.f, 0.f}; acc[i][1] = (f32x4){0.f, 0.f, 0.f, 0.f}; }
        const bf16_t* wg = wsm + (size_t)g * 128 * 128;
#pragma unroll 2
        for (int ks = 0; ks < nks; ++ks) {
            bf16x8 wfr[8];
#pragma unroll
            for (int it = 0; it < 8; ++it) if (it < nit) wfr[it] = ks == 0 ? wf0[it] : *(const bf16x8*)(wg + (it * 16 + fr) * 128 + ks * 32 + fq * 8);
            const bf16x8 va = *(const LAS bf16x8*)(VT + (wave * 32 + fr) * VPITCH + ks * 32 + fq * 8);
            const bf16x8 vb = *(const LAS bf16x8*)(VT + (wave * 32 + 16 + fr) * VPITCH + ks * 32 + fq * 8);
#pragma unroll
            for (int it = 0; it < 8; ++it) if (it < nit) {
                const bf16x8 wf = wfr[it];
                acc[it][0] = __builtin_amdgcn_mfma_f32_16x16x32_bf16(va, wf, acc[it][0], 0, 0, 0);
                acc[it][1] = __builtin_amdgcn_mfma_f32_16x16x32_bf16(vb, wf, acc[it][1], 0, 0, 0);
            }
        }
#pragma unroll
        for (int it = 0; it < 8; ++it) if (it < nit) {
            const int i = it * 16 + fr; const float bsv = bs[g * 128 + i];
#pragma unroll
            for (int ct = 0; ct < 2; ++ct) { const size_t off = (size_t)(row0 + i) * D + g * 256 + wave * 32 + ct * 16 + 4 * fq;
                const v2u uu = *(const v2u*)(U + off); const f32x4 m = acc[it][ct] + bsv;
                v2u o; o.x = pk2(bflo(uu.x) * m[0], bfhi(uu.x) * m[1]); o.y = pk2(bflo(uu.y) * m[2], bfhi(uu.y) * m[3]); *(v2u*)(SG + off) = o; }
        }
        __syncthreads();
    }
}

__device__ __forceinline__ void load8(const bf16_t* p, float (&o)[8]) { const v4u r = *(const v4u*)p; o[0] = bflo(r.x); o[1] = bfhi(r.x); o[2] = bflo(r.y); o[3] = bfhi(r.y); o[4] = bflo(r.z); o[5] = bfhi(r.z); o[6] = bflo(r.w); o[7] = bfhi(r.w); }
__device__ __forceinline__ void load8f(const float* p, float (&o)[8]) { const f32x4 a = *(const f32x4*)p, b = *(const f32x4*)(p + 4); o[0] = a[0]; o[1] = a[1]; o[2] = a[2]; o[3] = a[3]; o[4] = b[0]; o[5] = b[1]; o[6] = b[2]; o[7] = b[3]; }
__device__ __forceinline__ void ctr_arrive(unsigned* ctr, int tid) {
    asm volatile("s_waitcnt vmcnt(0)" ::: "memory"); __syncthreads();
    if (__builtin_amdgcn_readfirstlane(tid >> 6) == 0) { __builtin_amdgcn_fence(__ATOMIC_RELEASE, "agent"); asm volatile("s_waitcnt vmcnt(0)" ::: "memory");
        __hip_atomic_fetch_add(ctr, (tid & 63) == 0 ? 1u : 0u, __ATOMIC_RELAXED, __HIP_MEMORY_SCOPE_AGENT); }
}
__device__ __forceinline__ void ctr_wait(unsigned* ctr, unsigned need, int tid) {
    if (__builtin_amdgcn_readfirstlane(tid >> 6) == 0) {
        while ((unsigned)__builtin_amdgcn_readfirstlane((int)__hip_atomic_load(ctr, __ATOMIC_RELAXED, __HIP_MEMORY_SCOPE_AGENT)) < need) __builtin_amdgcn_s_sleep(2);
        __builtin_amdgcn_fence(__ATOMIC_ACQUIRE, "agent"); asm volatile("s_waitcnt vmcnt(0)" ::: "memory"); }
    __syncthreads();
}
__device__ __forceinline__ void conv_item(const bf16_t* A, bf16_t* Gb, const float* cw, const float* cb, const float* cst, int rb, int jc) {
    const int r0 = rb * 16, col = jc * 8;
    float w0g[8], w1g[8], w2g[8], bg[8], w0v[8], w1v[8], w2v[8], bv[8];
    load8f(cw + col, w0g); load8f(cw + DFF2 + col, w1g); load8f(cw + 2 * DFF2 + col, w2g); load8f(cb + col, bg);
    load8f(cw + DFF + col, w0v); load8f(cw + DFF2 + DFF + col, w1v); load8f(cw + 2 * DFF2 + DFF + col, w2v); load8f(cb + DFF + col, bv);
    float g2[8], g1[8], v2[8], v1[8];
    const int t0 = r0 < TP ? (r0 & (SEQP - 1)) : ((r0 - TP) & (SEQS - 1));
    if (t0 == 0) {
        if (r0 < TP) {
#pragma unroll
            for (int e = 0; e < 8; ++e) { g2[e] = 0.f; g1[e] = 0.f; v2[e] = 0.f; v1[e] = 0.f; }
        } else { const float* sp = cst + (size_t)((r0 - TP) >> 5) * 2 * DFF2 + col; load8f(sp, g2); load8f(sp + DFF2, g1); load8f(sp + DFF, v2); load8f(sp + DFF2 + DFF, v1); }
    } else { const bf16_t* ap = A + (size_t)(r0 - 2) * DFF2 + col; load8(ap, g2); load8(ap + DFF2, g1); load8(ap + DFF, v2); load8(ap + DFF2 + DFF, v1); }
#pragma unroll 2
    for (int i = 0; i < 16; ++i) {
        const bf16_t* ap = A + (size_t)(r0 + i) * DFF2 + col; float g0[8], v0[8]; load8(ap, g0); load8(ap + DFF, v0);
        float o[8];
#pragma unroll
        for (int e = 0; e < 8; ++e) { const float cgv = g0[e] * w2g[e] + g1[e] * w1g[e] + g2[e] * w0g[e] + bg[e], cvv = v0[e] * w2v[e] + v1[e] * w1v[e] + v2[e] * w0v[e] + bv[e];
            o[e] = cgv * __builtin_amdgcn_rcpf(1.0f + __builtin_amdgcn_exp2f(-LOG2E * cgv)) * cvv; g2[e] = g1[e]; g1[e] = g0[e]; v2[e] = v1[e]; v1[e] = v0[e]; }
        v4u w; w.x = pk2(o[0], o[1]); w.y = pk2(o[2], o[3]); w.z = pk2(o[4], o[5]); w.w = pk2(o[6], o[7]);
        *(v4u*)(Gb + (size_t)(r0 + i) * DFF + col) = w;
    }
}
__device__ __forceinline__ void conv_fix_item(const float* stash, bf16_t* Gb, const float* cw, const float* cb, int b, int jc) {
    const int col = jc * 8;
    float w0g[8], w1g[8], w2g[8], bg[8], w0v[8], w1v[8], w2v[8], bv[8];
    load8f(cw + col, w0g); load8f(cw + DFF2 + col, w1g); load8f(cw + 2 * DFF2 + col, w2g); load8f(cb + col, bg);
    load8f(cw + DFF + col, w0v); load8f(cw + DFF2 + DFF + col, w1v); load8f(cw + 2 * DFF2 + DFF + col, w2v); load8f(cb + DFF + col, bv);
    float g2[8], g1[8], v2[8], v1[8], c0g[8], c0v[8], c1g[8], c1v[8];
    const float* sb = stash + (size_t)b * 8 * DFF + col;
    load8f(sb, c0g); load8f(sb + DFF, c0v); load8f(sb + 2 * DFF, c1g); load8f(sb + 3 * DFF, c1v);
    if ((b & 127) == 0) {
#pragma unroll
        for (int e = 0; e < 8; ++e) { g2[e] = 0.f; g1[e] = 0.f; v2[e] = 0.f; v1[e] = 0.f; }
    } else { const float* sp = sb - (size_t)8 * DFF; load8f(sp + 4 * DFF, g2); load8f(sp + 5 * DFF, v2); load8f(sp + 6 * DFF, g1); load8f(sp + 7 * DFF, v1); }
    float o0[8], o1[8];
#pragma unroll
    for (int e = 0; e < 8; ++e) {
        const float a0 = c0g[e] * w2g[e] + g1[e] * w1g[e] + g2[e] * w0g[e] + bg[e], b0 = c0v[e] * w2v[e] + v1[e] * w1v[e] + v2[e] * w0v[e] + bv[e];
        const float a1 = c1g[e] * w2g[e] + c0g[e] * w1g[e] + g1[e] * w0g[e] + bg[e], b1 = c1v[e] * w2v[e] + c0v[e] * w1v[e] + v1[e] * w0v[e] + bv[e];
        o0[e] = a0 * __builtin_amdgcn_rcpf(1.0f + __builtin_amdgcn_exp2f(-LOG2E * a0)) * b0; o1[e] = a1 * __builtin_amdgcn_rcpf(1.0f + __builtin_amdgcn_exp2f(-LOG2E * a1)) * b1; }
    v4u w; w.x = pk2(o0[0], o0[1]); w.y = pk2(o0[2], o0[3]); w.z = pk2(o0[4], o0[5]); w.w = pk2(o0[6], o0[7]); *(v4u*)(Gb + (size_t)(b * 64) * DFF + col) = w;
    w.x = pk2(o1[0], o1[1]); w.y = pk2(o1[2], o1[3]); w.z = pk2(o1[4], o1[5]); w.w = pk2(o1[6], o1[7]); *(v4u*)(Gb + (size_t)(b * 64 + 1) * DFF + col) = w;
}
__device__ __forceinline__ bool conv_phase(ArgP a, int layer, int G, int tid, int bx, unsigned* ctr) {
    const bf16_t* A = (const bf16_t*)(a->ws + WS_A); bf16_t* Gb = (bf16_t*)(a->ws + WS_G);
    const float* cw = a->in[15] + (size_t)layer * 3 * DFF2; const float* cb = a->in[16] + (size_t)layer * DFF2; const float* cst = a->in[5] + (size_t)layer * NBS * 2 * DFF2;
    constexpr int NJC = DFF / 8; const bool split = G >= 64;
    if (split) {
        for (int it = bx * NTHR + tid; it < (TS / 16) * NJC; it += G * NTHR) { const int rbl = it / NJC; conv_item(A, Gb, cw, cb, cst, TP / 16 + rbl, it - rbl * NJC); }
        ctr_arrive(ctr, tid);
        if (bx < 32) { ctr_wait(ctr, (unsigned)G, tid); return true; }
    }
    const int skip = split ? 32 : 0, gt = (bx - skip) * NTHR + tid, NGT = (G - skip) * NTHR;
    if (!split) for (int it = gt; it < (TS / 16) * NJC; it += NGT) { const int rbl = it / NJC; conv_item(A, Gb, cw, cb, cst, TP / 16 + rbl, it - rbl * NJC); }
    const float* stash = (const float*)(a->ws + WS_A);
    for (int it = gt; it < (TP / 64) * NJC; it += NGT) { const int b = it / NJC; conv_fix_item(stash, Gb, cw, cb, b, it - b * NJC); }
    return false;
}

__device__ __forceinline__ void logf_units(ArgP a, int gw, int NGW, int lane) {
    const bf16_t* HB = (const bf16_t*)(a->ws + WS_HB); const bf16_t* wf = (const bf16_t*)(a->ws + WS_WF); const float* ssq = (const float*)(a->ws + WS_SSQ2);
    const int fr = lane & 15, fq = lane >> 4; const float bf = a->in[23][fr];
    for (int grp = gw; grp < T / 16; grp += NGW) {
        const int row0 = grp * 16; f32x4 acc = (f32x4){0.f, 0.f, 0.f, 0.f};
        const bf16_t* ap = HB + (size_t)(row0 + fr) * D + fq * 8; const bf16_t* bp = wf + (size_t)fr * D + fq * 8;
#pragma unroll 8
        for (int ks = 0; ks < 32; ++ks) acc = __builtin_amdgcn_mfma_f32_16x16x32_bf16(*(const bf16x8*)(ap + ks * 32), *(const bf16x8*)(bp + ks * 32), acc, 0, 0, 0);
#pragma unroll
        for (int r = 0; r < 4; ++r) { const int row = row0 + 4 * fq + r; const f32x4* sp = (const f32x4*)(ssq + (size_t)row * 16);
            const f32x4 s0 = sp[0], s1 = sp[1], s2 = sp[2], s3 = sp[3];
            const float ss = ((s0[0] + s0[1]) + (s0[2] + s0[3])) + ((s1[0] + s1[1]) + (s1[2] + s1[3])) + ((s2[0] + s2[1]) + (s2[2] + s2[3])) + ((s3[0] + s3[1]) + (s3[2] + s3[3]));
            const float x = acc[r] * __builtin_amdgcn_rsqf(ss * (1.f / 1024.f) + EPS) + bf;
            const float lf = fminf(x, 0.f) - log1pf(__expf(-fabsf(x)));
            a->out[(row < TP ? O_LFP + (size_t)row * 16 : O_LFS + (size_t)(row - TP) * 16) + fr] = lf; }
    }
}

__device__ __forceinline__ void scan_unit(const float* src0, int n0, int stride0, const float* src1, int n1, int stride1, float* dst, LAS float* sh, int tid, int wave, int lane, int* ktab = nullptr, float ref_off = 0.f) {
    const int n = n0 + n1, base = tid * 16; float v[16]; float s = 0.f;
    const float* sp = nullptr; int st = 0;
    if (base < n0) { sp = src0 + (size_t)base * stride0; st = stride0; } else if (base < n) { sp = src1 + (size_t)(base - n0) * stride1; st = stride1; }
    if (sp) {
#pragma unroll
        for (int e = 0; e < 16; ++e) v[e] = sp[(size_t)e * st];
    } else {
#pragma unroll
        for (int e = 0; e < 16; ++e) v[e] = 0.f;
    }
#pragma unroll
    for (int e = 0; e < 16; ++e) { s += v[e]; v[e] = s; }
    float sc = s;
#pragma unroll
    for (int o = 1; o < 64; o <<= 1) { const float t = __shfl_up(sc, o); if (lane >= o) sc += t; }
    if (lane == 63) sh[wave] = sc;
    __syncthreads();
    float pre = 0.f;
#pragma unroll
    for (int w = 0; w < NWAVES; ++w) if (w < wave) pre += sh[w];
    const float excl = pre + sc - s;
    if (ktab) {
        LAS float* tl = sh + 16;
        if ((tid & 3) == 3) tl[tid >> 2] = -(excl + v[15]) * LOG2E;
        if ((tid & 15) == 0) tl[128 + (tid >> 4)] = -(excl + v[0]) * LOG2E;
        __syncthreads();
        if (tid < 32) { const float ref = tl[128 + tid] - ref_off; int lo_ = 0, hi_ = 4 * tid;
            while (lo_ < hi_) { const int mid = (lo_ + hi_ + 1) >> 1; if (tl[mid - 1] < ref) lo_ = mid; else hi_ = mid - 1; }
            ktab[tid] = lo_ & ~1; }
    }
    if (base < n) {
#pragma unroll
        for (int e = 0; e < 16; e += 4) *(f32x4*)(dst + base + e) = (f32x4){-(excl + v[e]) * LOG2E, -(excl + v[e + 1]) * LOG2E, -(excl + v[e + 2]) * LOG2E, -(excl + v[e + 3]) * LOG2E};
    }
    __syncthreads();
}

__device__ __forceinline__ bf16x8 pack8(const f32x4 a, const f32x4 b) { v4u w; w.x = pk2(a[0], a[1]); w.y = pk2(a[2], a[3]); w.z = pk2(b[0], b[1]); w.w = pk2(b[2], b[3]); return __builtin_bit_cast(bf16x8, w); }
__device__ __forceinline__ void attn_sample_unit(ArgP a, int s, int h, LAS unsigned char* lds, int tid, int wave, int lane) {
    const bf16_t* Q = (const bf16_t*)(a->ws + WS_R0); const bf16_t* Kn = (const bf16_t*)(a->ws + WS_R1); const bf16_t* Vn = (const bf16_t*)(a->ws + WS_R2); bf16_t* O = (bf16_t*)(a->ws + WS_R0);
    const float* kb = (const float*)(a->ws + WS_CKS) + (size_t)(s * NH + h) * SKS;
    const float* ck = a->in[2] + ((size_t)s * PAST * NH + h) * HD; const float* cv = a->in[3] + ((size_t)s * PAST * NH + h) * HD;
    const int r32 = lane & 31, hi = lane >> 5, row0 = TP + s * SEQS;
    bf16x8 qr[4];
#pragma unroll
    for (int d0 = 0; d0 < 4; ++d0) qr[d0] = *(const bf16x8*)(Q + (size_t)(row0 + r32) * D + h * HD + d0 * 16 + hi * 8);
    float m = -1e30f, l = 0.f; f32x16 o0 = {}, o1 = {};
#define SMP_TILE(kf, vf, kbp, MASK) do { f32x16 p; \
        _Pragma("unroll") for (int g_ = 0; g_ < 4; ++g_) { const f32x4 bb = *(const f32x4*)((kbp) + 8 * g_ + 4 * hi); p[4 * g_] = bb[0]; p[4 * g_ + 1] = bb[1]; p[4 * g_ + 2] = bb[2]; p[4 * g_ + 3] = bb[3]; } \
        _Pragma("unroll") for (int d0 = 0; d0 < 4; ++d0) p = __builtin_amdgcn_mfma_f32_32x32x16_bf16(kf[d0], qr[d0], p, 0, 0, 0); \
        if (MASK) { _Pragma("unroll") for (int r = 0; r < 16; ++r) { const int key = (r & 3) + 8 * (r >> 2) + 4 * hi; if (key > r32) p[r] = -1e30f; } } \
        float mx = p[0]; _Pragma("unroll") for (int r = 1; r < 16; ++r) mx = fmaxf(mx, p[r]); \
        mx = fmaxf(mx, __shfl_xor(mx, 32)); const float mn = fmaxf(m, mx), f = __builtin_amdgcn_exp2f(m - mn); m = mn; float ls = 0.f; \
        _Pragma("unroll") for (int r = 0; r < 16; ++r) { p[r] = __builtin_amdgcn_exp2f(p[r] - mn); ls += p[r]; } \
        l = l * f + ls; o0 = o0 * f; o1 = o1 * f; \
        v4u w0, w1; w0.x = pk2(p[0], p[1]); w0.y = pk2(p[2], p[3]); w0.z = pk2(p[4], p[5]); w0.w = pk2(p[6], p[7]); w1.x = pk2(p[8], p[9]); w1.y = pk2(p[10], p[11]); w1.z = pk2(p[12], p[13]); w1.w = pk2(p[14], p[15]); \
        const bf16x8 pw0 = __builtin_bit_cast(bf16x8, w0), pw1 = __builtin_bit_cast(bf16x8, w1); \
        o0 = __builtin_amdgcn_mfma_f32_32x32x16_bf16(vf[0][0], pw0, o0, 0, 0, 0); o0 = __builtin_amdgcn_mfma_f32_32x32x16_bf16(vf[0][1], pw1, o0, 0, 0, 0); \
        o1 = __builtin_amdgcn_mfma_f32_32x32x16_bf16(vf[1][0], pw0, o1, 0, 0, 0); o1 = __builtin_amdgcn_mfma_f32_32x32x16_bf16(vf[1][1], pw1, o1, 0, 0, 0); } while (0)
    f32x4 kraw[8]; float vraw[32];
#define SMP_LOAD(tt_) do { const int key0_ = (wave * 16 + (tt_)) * 32; const float* kp_ = ck + (size_t)(key0_ + r32) * (NH * HD) + hi * 8; \
        _Pragma("unroll") for (int d0 = 0; d0 < 4; ++d0) { kraw[2 * d0] = *(const f32x4*)(kp_ + d0 * 16); kraw[2 * d0 + 1] = *(const f32x4*)(kp_ + d0 * 16 + 4); } \
        _Pragma("unroll") for (int d0b = 0; d0b < 2; ++d0b) _Pragma("unroll") for (int ks = 0; ks < 2; ++ks) _Pragma("unroll") for (int e = 0; e < 8; ++e) \
            vraw[(d0b * 2 + ks) * 8 + e] = cv[(size_t)(key0_ + 16 * ks + 4 * hi + (e & 3) + 8 * (e >> 2)) * (NH * HD) + d0b * 32 + r32]; } while (0)
    SMP_LOAD(0);
    for (int tt = 0; tt < 16; ++tt) {
        const int key0 = (wave * 16 + tt) * 32;
        bf16x8 kf[4], vf[2][2];
#pragma unroll
        for (int d0 = 0; d0 < 4; ++d0) kf[d0] = pack8(kraw[2 * d0], kraw[2 * d0 + 1]);
#pragma unroll
        for (int d0b = 0; d0b < 2; ++d0b)
#pragma unroll
            for (int ks = 0; ks < 2; ++ks) { const float* x = vraw + (d0b * 2 + ks) * 8; vf[d0b][ks] = pack8((f32x4){x[0], x[1], x[2], x[3]}, (f32x4){x[4], x[5], x[6], x[7]}); }
        if (tt + 1 < 16) SMP_LOAD(tt + 1);
        SMP_TILE(kf, vf, kb + key0, false);
    }
#undef SMP_LOAD
    if (wave == 0) {
        bf16x8 kf[4], vf[2][2];
#pragma unroll
        for (int d0 = 0; d0 < 4; ++d0) kf[d0] = *(const bf16x8*)(Kn + (size_t)(row0 + r32) * D + h * HD + d0 * 16 + hi * 8);
#pragma unroll
        for (int d0b = 0; d0b < 2; ++d0b)
#pragma unroll
            for (int ks = 0; ks < 2; ++ks) { unsigned x[8];
#pragma unroll
                for (int e = 0; e < 8; ++e) x[e] = Vn[(size_t)(row0 + 16 * ks + 4 * hi + (e & 3) + 8 * (e >> 2)) * D + h * HD + d0b * 32 + r32];
                v4u w; w.x = x[0] | (x[1] << 16); w.y = x[2] | (x[3] << 16); w.z = x[4] | (x[5] << 16); w.w = x[6] | (x[7] << 16); vf[d0b][ks] = __builtin_bit_cast(bf16x8, w); }
        SMP_TILE(kf, vf, kb + PAST, true);
    }
#undef SMP_TILE
    l += __shfl_xor(l, 32);
    LAS float* po = (LAS float*)lds + wave * 2048; LAS float* pm = (LAS float*)(lds + 65536) + wave * 64;
#pragma unroll
    for (int r = 0; r < 16; ++r) { const int d = (r & 3) + 8 * (r >> 2) + 4 * hi; po[d * 32 + r32] = o0[r]; po[(d + 32) * 32 + r32] = o1[r]; }
    if (hi == 0) { pm[r32] = m; pm[32 + r32] = l; }
    __syncthreads();
    { const int q = tid & 31, d0 = (tid >> 5) * 4; float M = -1e30f;
#pragma unroll
        for (int w = 0; w < NWAVES; ++w) M = fmaxf(M, ((LAS float*)(lds + 65536))[w * 64 + q]);
        float L = 0.f, oo[4] = {0.f, 0.f, 0.f, 0.f};
#pragma unroll
        for (int w = 0; w < NWAVES; ++w) { const float f = __builtin_amdgcn_exp2f(((LAS float*)(lds + 65536))[w * 64 + q] - M); L += f * ((LAS float*)(lds + 65536))[w * 64 + 32 + q];
#pragma unroll
            for (int e = 0; e < 4; ++e) oo[e] += f * ((LAS float*)lds)[w * 2048 + (d0 + e) * 32 + q]; }
        const float rl = 1.0f / L; v2u o; o.x = pk2(oo[0] * rl, oo[1] * rl); o.y = pk2(oo[2] * rl, oo[3] * rl);
        *(v2u*)(O + (size_t)(row0 + q) * D + h * HD + d0) = o; }
    __syncthreads();
}

constexpr int NPHASE = 14;
__global__ void __launch_bounds__(NTHR, 2) yoco_fwd(Args args) {
    extern __shared__ __attribute__((aligned(16))) unsigned char lds_raw[];
    cg::grid_group grid = cg::this_grid();
    LAS unsigned char* lds = (LAS unsigned char*)lds_raw;
    const int G = gridDim.x, bx = blockIdx.x, vcu = (G % 8 == 0) ? (bx % 8) * (G / 8) + bx / 8 : bx;
    const int NGW = G * NWAVES;
    const int wv0 = __builtin_amdgcn_readfirstlane((int)threadIdx.x >> 6);
    const int vblk = bx;
#define MYTID() ((wv0 << 6) | (int)__builtin_amdgcn_mbcnt_hi(~0u, __builtin_amdgcn_mbcnt_lo(~0u, 0u)))
#define TIDS() const int tid = ({ int t_ = MYTID(); asm volatile("" : "+v"(t_)); t_; }), lane = tid & 63, wave = __builtin_amdgcn_readfirstlane(tid >> 6), gw = vcu * NWAVES + wave; (void)lane; (void)gw
    ArgP argp = (ArgP)__builtin_amdgcn_kernarg_segment_ptr();
#define AP() ({ ArgP p_ = argp; asm volatile("" : "+s"(p_)); p_; })
    unsigned char* ws = args.ws; float* out = args.out;
    const int lo = args.ph_lo, hi = args.ph_hi;
#define IN(k) (lo <= (k) && (k) < hi)
#ifndef PROBE_DUP
#define PROBE_DUP 0
#endif
#define REP(k) for (int rep_ = 0; rep_ <= ((PROBE_DUP >> (k)) & 1); ++rep_)
#define SEAM(k) do { if (IN(k) && IN((k) + 1)) { if ((k) == 0) grid.sync(); else { const int t_ = MYTID(); unsigned* gb_ = (unsigned*)args.ws + 1024; ctr_arrive(gb_, t_); ctr_wait(gb_, (unsigned)(G * (k)), t_); } } } while (0)
    bf16_t* R0 = (bf16_t*)(ws + WS_R0); bf16_t* R1 = (bf16_t*)(ws + WS_R1); bf16_t* R2 = (bf16_t*)(ws + WS_R2); bf16_t* HB = (bf16_t*)(ws + WS_HB);
    bf16_t* Ab = (bf16_t*)(ws + WS_A); bf16_t* Gb = (bf16_t*)(ws + WS_G); float* HF = out + O_Y;
    float* ssq0 = (float*)(ws + WS_SSQ0); float* ssq1 = (float*)(ws + WS_SSQ1); float* ssq2 = (float*)(ws + WS_SSQ2); float* ssq3 = (float*)(ws + WS_SSQ3);

    if (IN(0)) REP(0) { if (rep_) grid.sync(); TIDS();
        if (p0_prologue(AP(), lds, G, bx, tid, wave, lane, (unsigned*)ws + 2112)) {
            pg8::Gemm g{R0, (const bf16_t*)(ws + WS_WIN), T, 2 * D, D}; pg8::OneUnit S{TP / 256 + (bx >> 3), bx & 7};
            pg8::EpiSguIn E{ssq0, R1, R2, (float*)(ws + WS_VSTAT)};
            pg8::gemm_phase<pg8::EpiSguIn, pg8::OneUnit, true, true>(lds, g, S, E, wv0); } }
    SEAM(0);
    if (IN(1)) REP(1) { if (rep_) grid.sync();
        pg8::Gemm g{R0, (const bf16_t*)(ws + WS_WIN), T, 2 * D, D}; pg8::StaticOrder S; S.init(G >= 32 ? TP : T, 2 * D, G, vblk);
        pg8::EpiSguIn E{ssq0, R1, R2, (float*)(ws + WS_VSTAT)};
        pg8::gemm_phase<pg8::EpiSguIn, pg8::StaticOrder, true, true>(lds, g, S, E, wv0);
    }
    SEAM(1);
    if (IN(2)) REP(2) { if (rep_) grid.sync(); TIDS();
        unsigned* q2 = (unsigned*)ws + 320; unsigned* c_sgus = (unsigned*)ws + 384; unsigned* c_p3s = (unsigned*)ws + 448;
        LAS unsigned* ubox = (LAS unsigned*)(lds + RING_BYTES);
        constexpr unsigned S_A = 64, S_B = S_A + 256, S_C = S_B + 8, S_D = S_C + 512, S_E = S_D + 44, S_END = S_E + 256;
        int qit_ = 0;
        for (;;) {
            if (wave == 0) ubox[qit_ & 1] = (unsigned)__builtin_amdgcn_readfirstlane((int)__hip_atomic_fetch_add(q2, lane == 0 ? 1u : 0u, __ATOMIC_RELAXED, __HIP_MEMORY_SCOPE_AGENT));
            __syncthreads();
            const unsigned un = (unsigned)__builtin_amdgcn_readfirstlane((int)ubox[qit_ & 1]);
            ++qit_;
            if (un >= S_END) break;
            int v;
            if (un < S_A) { sgu_unit(AP(), lds, 1024 + (int)un, tid, wave, lane); ctr_arrive(c_sgus, tid); continue; }
            else if (un < S_B) v = (int)(un - S_A);
            else if (un < S_C) { const int k = (int)(un - S_B); ctr_wait(c_sgus, 64u, tid);
                pg8::Gemm g{Gb, (const bf16_t*)(ws + WS_WOUT), T, D, D}; pg8::OneUnit S{TP / 256 + (k >> 2), k & 3}; pg8::EpiRes<false> E{R0, HB, ssq1, nullptr};
                pg8::gemm_phase<pg8::EpiRes<false>, pg8::OneUnit, true, true>(lds, g, S, E, wv0);
                ctr_arrive(c_p3s, tid); continue; }
            else if (un < S_D) v = (int)(un - S_C) + 256;
            else if (un < S_E) { const int k = (int)(un - S_D); ctr_wait(c_p3s, 8u, tid);
                pg8::Gemm g{HB, (const bf16_t*)(ws + WS_WUP0), T, DFF2, D}; pg8::OneUnit S{TP / 256 + k / 22, k % 22}; pg8::EpiUp<true> E{ssq1, Ab, Gb, (float*)(ws + WS_A), out + O_CONVP, out + O_CONVS, AP()->in[15], AP()->in[16]};
                pg8::gemm_phase<pg8::EpiUp<true>, pg8::OneUnit, true, true>(lds, g, S, E, wv0);
                continue; }
            else v = (int)(un - S_E) + 768;
            sgu_unit(AP(), lds, v, tid, wave, lane);
        }
    }
    SEAM(2);
    if (IN(3)) REP(3) { if (rep_) grid.sync();
        pg8::Gemm g{Gb, (const bf16_t*)(ws + WS_WOUT), T, D, D}; pg8::StaticOrder S; S.init(TP, D, G, vblk);
        pg8::EpiRes<false> E{R0, HB, ssq1, nullptr};
        pg8::gemm_phase<pg8::EpiRes<false>, pg8::StaticOrder, true, true>(lds, g, S, E, wv0);
    }
    SEAM(3);
    if (IN(4)) REP(4) { if (rep_) grid.sync();
        pg8::Gemm g{HB, (const bf16_t*)(ws + WS_WUP0), T, DFF2, D}; pg8::StaticOrder S; S.init(TP, DFF2, G, vblk);
        pg8::EpiUp<false> E{ssq1, Ab, Gb, (float*)(ws + WS_A), out + O_CONVP, out + O_CONVS, AP()->in[15], AP()->in[16]};
        pg8::gemm_phase<pg8::EpiUp<false>, pg8::StaticOrder, true, true>(lds, g, S, E, wv0);
    }
    SEAM(4);
    if (IN(5)) REP(5) { if (rep_) grid.sync(); TIDS();
        if (conv_phase(AP(), 0, G, tid, bx, (unsigned*)ws + 64)) {
            const int un_ = bx >> 2, qk = bx & 3, koff = qk < 2 ? qk * 768 : 1536 + (qk - 2) * 640, klen = qk < 2 ? 768 : 640;
            float* part = (float*)(ws + WS_R1) + (size_t)un_ * 3 * 65536; unsigned* pc = (unsigned*)ws + 1088 + 64 * un_;
            pg8::Gemm g{Gb + koff, (const bf16_t*)(ws + WS_WDN0) + koff, T, D, DFF, klen}; pg8::OneUnit S{TP / 256 + (un_ >> 2), un_ & 3};
            if (qk < 3) { pg8::EpiPart E{part + (size_t)qk * 65536, pc}; pg8::gemm_phase<pg8::EpiPart, pg8::OneUnit, true, true>(lds, g, S, E, wv0); }
            else { pg8::EpiRes<false, true> E{HB, HB, ssq2, nullptr, part, pc}; pg8::gemm_phase<pg8::EpiRes<false, true>, pg8::OneUnit, true, true>(lds, g, S, E, wv0); } } }
    SEAM(5);
    if (IN(6)) REP(6) { if (rep_) grid.sync();
        pg8::Gemm g{Gb, (const bf16_t*)(ws + WS_WDN0), T, D, DFF}; pg8::StaticOrder S; S.init(G >= 64 ? TP : T, D, G, vblk);
        pg8::EpiRes<false> E{HB, HB, ssq2, nullptr};
        pg8::gemm_phase<pg8::EpiRes<false>, pg8::StaticOrder, true, true>(lds, g, S, E, wv0);
    }
    SEAM(6);
    if (IN(7)) REP(7) { if (rep_) grid.sync();
        pg8::Gemm g{HB, (const bf16_t*)(ws + WS_WQKV), T, 3 * D, D}; pg8::StaticOrder S; S.init(T, 3 * D, G, vblk);
        pg8::EpiQKV E{ssq2, R0, R1, R2, out + O_KP, out + O_KS, out + O_VP, out + O_VS, AP()->in[25], AP()->in[21], C2};
        pg8::gemm_phase<pg8::EpiQKV, pg8::StaticOrder, true, true>(lds, g, S, E, wv0);
        { TIDS(); logf_units(AP(), gw, NGW, lane); }
    }
    SEAM(7);
    if (IN(8)) REP(8) { if (rep_) grid.sync();
        TIDS(); LAS float* sh = (LAS float*)lds;
        for (int un = bx; un < NBP * NH + NBS * NH; un += G) {
            if (un < NBP * NH) { const int b = un >> 4, h = un & 15;
                float mg8;
                { float a_ = fabsf(AP()->in[25][lane]), b_ = fabsf(AP()->in[21][lane]);
#pragma unroll
                    for (int o = 1; o < 64; o <<= 1) { a_ = fmaxf(a_, __shfl_xor(a_, o)); b_ = fmaxf(b_, __shfl_xor(b_, o)); }
                    mg8 = 64.f * C2 * a_ * b_ * 1.02f; }
                scan_unit(out + O_LFP + (size_t)b * SEQP * NH + h, SEQP, NH, nullptr, 0, 0, (float*)(ws + WS_CKP) + (size_t)un * SEQP, sh, tid, wave, lane, (int*)(ws + 32768) + un * 32, 2.f * mg8 + 150.f); }
            else { const int us = un - NBP * NH, s = us >> 4, h = us & 15;
                scan_unit(AP()->in[4] + (size_t)s * PAST * NH + h, PAST, NH, out + O_LFS + (size_t)s * SEQS * NH + h, SEQS, NH, (float*)(ws + WS_CKS) + (size_t)us * SKS, sh, tid, wave, lane); }
        }
    }
    SEAM(8);
    if (IN(9)) REP(9) { if (rep_) grid.sync();
        TIDS();
        unsigned* qctr = (unsigned*)ws;
        LAS unsigned* ubox = (LAS unsigned*)(lds + RING_BYTES);
        float mg;
        { const float gq = fabsf(AP()->in[25][lane]), gk = fabsf(AP()->in[21][lane]); float a_ = gq, b_ = gk;
#pragma unroll
            for (int o = 1; o < 64; o <<= 1) { a_ = fmaxf(a_, __shfl_xor(a_, o)); b_ = fmaxf(b_, __shfl_xor(b_, o)); }
            mg = 64.f * C2 * a_ * b_ * 1.02f; }
        constexpr unsigned Q_A = 1024, Q_B = Q_A + 8, Q_C = Q_B + 512, Q_D = Q_C + 44, Q_END = Q_D + 768, Q_S = NBS * NH;
        unsigned* c_attn = (unsigned*)ws + 192; unsigned* c_wo = (unsigned*)ws + 256;
        int qit_ = 0;
        for (;;) {
            if (wave == 0) ubox[qit_ & 1] = (unsigned)__builtin_amdgcn_readfirstlane((int)__hip_atomic_fetch_add(qctr, lane == 0 ? 1u : 0u, __ATOMIC_RELAXED, __HIP_MEMORY_SCOPE_AGENT));
            __syncthreads();
            const unsigned un = (unsigned)__builtin_amdgcn_readfirstlane((int)ubox[qit_ & 1]);
            ++qit_;
            if (un >= Q_END) break;
            int v;
            if (un < Q_A) {
                if ((un & 3u) == 0u) { const int su = (int)(un >> 2); int t2 = MYTID(); asm volatile("" : "+v"(t2));
                    attn_sample_unit(AP(), su >> 4, su & 15, lds, t2, __builtin_amdgcn_readfirstlane(t2 >> 6), t2 & 63); ctr_arrive(c_attn, t2); continue; }
                v = (int)(un >> 2) * 3 + (int)(un & 3u) - 1;
            }
            else if (un < Q_B) {
                const int k = (int)(un - Q_A); ctr_wait(c_attn, Q_S, tid);
                pg8::Gemm g{R0, (const bf16_t*)(ws + WS_WO), T, D, D}; pg8::OneUnit S{TP / 256 + (k >> 2), k & 3}; pg8::EpiRes<false> E{HB, HB, ssq3, nullptr};
                pg8::gemm_phase<pg8::EpiRes<false>, pg8::OneUnit, true, true>(lds, g, S, E, wv0);
                ctr_arrive(c_wo, tid); continue; }
            else if (un < Q_C) v = (int)(un - Q_B) + 768;
            else if (un < Q_D) {
                const int k = (int)(un - Q_C); ctr_wait(c_wo, 8u, tid);
                pg8::Gemm g{HB, (const bf16_t*)(ws + WS_WUP1), T, DFF2, D}; pg8::OneUnit S{TP / 256 + k / 22, k % 22};
                pg8::EpiUp<true> E{ssq3, Ab, Gb, (float*)(ws + WS_A), out + O_CONVP + (size_t)NBP * 2 * DFF2, out + O_CONVS + (size_t)NBS * 2 * DFF2, AP()->in[15] + (size_t)3 * DFF2, AP()->in[16] + DFF2};
                pg8::gemm_phase<pg8::EpiUp<true>, pg8::OneUnit, true, true>(lds, g, S, E, wv0);
                continue; }
            else v = (int)(un - Q_D) + 1280;
            const int qb = 31 - (v >> 6), bh = v & 63, q0 = qb * 256;
            const int kt0 = __builtin_amdgcn_readfirstlane(((const int*)(ws + 32768))[bh * 32 + qb]);
            { const f32x4* src = (const f32x4*)((const float*)(ws + WS_CKP) + (size_t)bh * SEQP); LAS f32x4* dst = (LAS f32x4*)(lds + attn_body::LDS_BIAS);
                for (int k = 16 * kt0 + tid; k < (q0 + 256) / 4; k += NTHR) dst[k] = src[k]; }
            __syncthreads();
            attn_body::attn_unit<40>(wv0, bh >> 4, bh & 15, qb, kt0, (const attn_body::bf16*)R0, (const attn_body::bf16*)R1, (const attn_body::bf16*)R2, (attn_body::bf16*)R0, (char*)lds_raw);
        }
    }
    SEAM(9);
    if (IN(10)) REP(10) { if (rep_) grid.sync();
        pg8::Gemm g{R0, (const bf16_t*)(ws + WS_WO), T, D, D}; pg8::StaticOrder S; S.init(TP, D, G, vblk);
        pg8::EpiRes<false> E{HB, HB, ssq3, nullptr};
        pg8::gemm_phase<pg8::EpiRes<false>, pg8::StaticOrder, true, true>(lds, g, S, E, wv0);
    }
    SEAM(10);
    if (IN(11)) REP(11) { if (rep_) grid.sync();
        pg8::Gemm g{HB, (const bf16_t*)(ws + WS_WUP1), T, DFF2, D}; pg8::StaticOrder S; S.init(TP, DFF2, G, vblk);
        pg8::EpiUp<false> E{ssq3, Ab, Gb, (float*)(ws + WS_A), out + O_CONVP + (size_t)NBP * 2 * DFF2, out + O_CONVS + (size_t)NBS * 2 * DFF2, AP()->in[15] + (size_t)3 * DFF2, AP()->in[16] + DFF2};
        pg8::gemm_phase<pg8::EpiUp<false>, pg8::StaticOrder, true, true>(lds, g, S, E, wv0);
    }
    SEAM(11);
    if (IN(12)) REP(12) { if (rep_) grid.sync(); TIDS();
        if (conv_phase(AP(), 1, G, tid, bx, (unsigned*)ws + 128)) {
            const int un_ = bx >> 2, qk = bx & 3, koff = qk < 2 ? qk * 768 : 1536 + (qk - 2) * 640, klen = qk < 2 ? 768 : 640;
            float* part = (float*)(ws + WS_R1) + (size_t)un_ * 3 * 65536; unsigned* pc = (unsigned*)ws + 1088 + 64 * (8 + un_);
            pg8::Gemm g{Gb + koff, (const bf16_t*)(ws + WS_WDN1) + koff, T, D, DFF, klen}; pg8::OneUnit S{TP / 256 + (un_ >> 2), un_ & 3};
            if (qk < 3) { pg8::EpiPart E{part + (size_t)qk * 65536, pc}; pg8::gemm_phase<pg8::EpiPart, pg8::OneUnit, true, true>(lds, g, S, E, wv0); }
            else { pg8::EpiRes<true, true> E{HB, nullptr, nullptr, HF, part, pc}; pg8::gemm_phase<pg8::EpiRes<true, true>, pg8::OneUnit, true, true>(lds, g, S, E, wv0); } } }
    SEAM(12);
    if (IN(13)) REP(13) { if (rep_) grid.sync();
        pg8::Gemm g{Gb, (const bf16_t*)(ws + WS_WDN1), T, D, DFF}; pg8::StaticOrder S; S.init(G >= 64 ? TP : T, D, G, vblk);
        pg8::EpiRes<true> E{HB, nullptr, nullptr, HF};
        pg8::gemm_phase<pg8::EpiRes<true>, pg8::StaticOrder, true, true>(lds, g, S, E, wv0);
    }
#undef IN
#undef SEAM
}

#ifndef MK_N_LAUNCHES
#define MK_N_LAUNCHES 1
#endif
extern "C" void kernel_launch(void* const* d_in, const int* in_sizes, int n_in, void* d_out, int out_size, void* d_ws, size_t ws_size, hipStream_t stream) {
    static int grid = 0;
    if (grid == 0) {
        if (n_in != 27 || (size_t)out_size != O_END || ws_size < WS_END) { fprintf(stderr, "kernel_launch: unexpected shapes (n_in %d out %d ws %zu)\n", n_in, out_size, ws_size); grid = -1; return; }
        int dev = 0, cus = 0, per_cu = 0;
        hipGetDevice(&dev); hipDeviceGetAttribute(&cus, hipDeviceAttributeMultiprocessorCount, dev);
        if (hipFuncSetAttribute((const void*)yoco_fwd, hipFuncAttributeMaxDynamicSharedMemorySize, LDS_BYTES) != hipSuccess) { fprintf(stderr, "kernel_launch: hipFuncSetAttribute failed\n"); grid = -1; return; }
        if (hipOccupancyMaxActiveBlocksPerMultiprocessor(&per_cu, (const void*)yoco_fwd, NTHR, LDS_BYTES) != hipSuccess || per_cu < 1) { fprintf(stderr, "kernel_launch: occupancy query says %d\n", per_cu); per_cu = 1; }
        (void)hipGetLastError();
        grid = cus * 1;
    }
    if (grid < 0) return;
    if (hipMemsetAsync(d_ws, 0, 16384, stream) != hipSuccess) { fprintf(stderr, "kernel_launch: hipMemsetAsync failed\n"); return; }
    Args a{};
    for (int i = 0; i < 27; ++i) a.in[i] = (const float*)d_in[i];
    a.out = (float*)d_out; a.ws = (unsigned char*)d_ws;
    constexpr int NL = MK_N_LAUNCHES;
    for (int li = 0; li < NL; ++li) {
        a.ph_lo = (NL == 1) ? 0 : li; a.ph_hi = (NL == 1) ? NPHASE : li + 1;
        void* kargs[] = {&a};
        hipError_t e = hipLaunchCooperativeKernel((const void*)yoco_fwd, dim3(grid), dim3(NTHR), kargs, LDS_BYTES, stream);
        if (e != hipSuccess) { fprintf(stderr, "kernel_launch: cooperative launch failed: %s (grid %d)\n", hipGetErrorString(e), grid); break; }
    }
}
```
